# Optimizing an MI355X kernel written in HIP

```python
import jax, jax.numpy as jnp
from jax import lax
import numpy as np

D_MODEL = 1024
BATCH = 4
SEQ = 4096
DEPTH = 1

HG_WIDTH = D_MODEL // 2
NSA_WIDTH = D_MODEL - HG_WIDTH
HG_EXPAND = 128
HG_HEADS = HG_WIDTH // HG_EXPAND
HG_DK = HG_EXPAND
HG_DV = HG_WIDTH // HG_HEADS
HG_CHUNK = 64
NSA_HEAD_DIM = 64
NSA_HEADS = NSA_WIDTH // NSA_HEAD_DIM
NSA_KV_GROUPS = 2
NSA_GROUP_SIZE = NSA_HEADS // NSA_KV_GROUPS
CMP_BLOCK = 32
CMP_STRIDE = 16
CMP_HIDDEN = 256
SLC_BLOCK = 64
SLC_TOPN = 16
WINDOW = 512
Q_BLOCK = 128
NEG = -1e30
FORCE = 1e4
D_FF = -(-8 * D_MODEL // (3 * 256)) * 256
ALPHA = (2.0 * DEPTH) ** 0.25
BETA = (8.0 * DEPTH) ** -0.25
LN_EPS = 1e-5
RMS_EPS = 1e-6
KV_W = NSA_KV_GROUPS * NSA_HEAD_DIM
IN_SIZES = [HG_WIDTH] * 4 + [NSA_WIDTH] + [KV_W] * 6 + [3 * NSA_HEADS]
IN_COLS = sum(IN_SIZES)

kernel_name = "hybrid_hgrn2_nsa_deepnorm_adaln_block"


def layer_norm(x, g, b):
    xf = x.astype(jnp.float32)
    mu = jnp.mean(xf, -1, keepdims=True)
    var = jnp.mean(jnp.square(xf - mu), -1, keepdims=True)
    return ((xf - mu) * lax.rsqrt(var + LN_EPS) * g + b).astype(x.dtype)


def alibi_slopes():
    s = 2.0 ** (-8.0 * (np.arange(NSA_HEADS) + 1) / NSA_HEADS)
    return jnp.asarray(s, jnp.float32).reshape(NSA_KV_GROUPS, NSA_GROUP_SIZE)


def hgrn2_mixer(q, f_logit, inp, g, lb, norm_g):
    B, T, _ = q.shape
    nc = T // HG_CHUNK
    f = lb + (1.0 - lb) * jax.nn.sigmoid(f_logit)
    log_f = jnp.log(f)
    k = 1.0 - f
    qf = jax.nn.silu(q)

    def to_chunks(a, dh):
        return a.reshape(B, nc, HG_CHUNK, HG_HEADS, dh).transpose(1, 0, 3, 2, 4)

    qc, kc, gc = to_chunks(qf, HG_DK), to_chunks(k, HG_DK), to_chunks(log_f, HG_DK)
    vc = to_chunks(inp, HG_DV)
    causal = jnp.tril(jnp.ones((HG_CHUNK, HG_CHUNK), bool))[:, :, None]

    def step(S, xs):
        qq, kk, vv, ll = xs
        b = jnp.cumsum(ll, axis=2)
        diff = b[:, :, :, None, :] - b[:, :, None, :, :]
        decay = jnp.exp(jnp.where(causal, diff, -jnp.inf))
        attn = jnp.einsum('bhtd,bhsd,bhtsd->bhts', qq, kk, decay)
        o = jnp.einsum('bhts,bhsv->bhtv', attn, vv) + jnp.einsum('bhtd,bhdv->bhtv', qq * jnp.exp(b), S)
        b_last = b[:, :, -1:, :]
        S = jnp.exp(b_last[:, :, 0, :])[..., None] * S + jnp.einsum('bhsd,bhsv->bhdv', kk * jnp.exp(b_last - b), vv)
        return S, o

    S0 = jnp.zeros((B, HG_HEADS, HG_DK, HG_DV), jnp.float32)
    _, o = lax.scan(step, S0, (qc, kc, vc, gc))
    o = o.transpose(1, 0, 3, 2, 4).reshape(B, T, HG_HEADS, HG_DV)
    o = o * lax.rsqrt(jnp.mean(jnp.square(o), -1, keepdims=True) + RMS_EPS)
    return o.reshape(B, T, HG_WIDTH) * norm_g * jax.nn.sigmoid(g)


def nsa_mixer(q, k_c, v_c, k_s, v_s, k_w, v_w, gate_logits,
              pos_k, w1_k, w2_k, pos_v, w1_v, w2_v):
    B, T, _ = q.shape
    G, Hg, dh = NSA_KV_GROUPS, NSA_GROUP_SIZE, NSA_HEAD_DIM
    scale = dh ** -0.5
    slopes = alibi_slopes()
    kv = lambda a: a.reshape(B, T, G, dh)
    k_c, v_c, k_s, v_s, k_w, v_w = map(kv, (k_c, v_c, k_s, v_s, k_w, v_w))

    n_cmp = (T - CMP_BLOCK) // CMP_STRIDE + 1
    tok_idx = jnp.arange(n_cmp)[:, None] * CMP_STRIDE + jnp.arange(CMP_BLOCK)[None, :]

    def compress(a, pos, w1, w2):
        blk = a[:, tok_idx] + pos[None, None, :, None, :]
        blk = blk.transpose(0, 1, 3, 2, 4).reshape(B, n_cmp, G, CMP_BLOCK * dh)
        return jax.nn.gelu(blk @ w1) @ w2

    k_cmp = compress(k_c, pos_k, w1_k, w2_k)
    v_cmp = compress(v_c, pos_v, w1_v, w2_v)
    cmp_end = jnp.arange(n_cmp) * CMP_STRIDE + CMP_BLOCK - 1

    n_slc = T // SLC_BLOCK
    top_n = min(SLC_TOPN, n_slc)
    cs = jnp.arange(n_cmp) * CMP_STRIDE
    ss = jnp.arange(n_slc) * SLC_BLOCK
    overlap = jnp.clip(jnp.minimum(cs[:, None] + CMP_BLOCK, ss[None] + SLC_BLOCK)
                       - jnp.maximum(cs[:, None], ss[None]), 0).astype(jnp.float32) / CMP_BLOCK
    k_slc = k_s.reshape(B, n_slc, SLC_BLOCK, G, dh).transpose(0, 3, 1, 2, 4)
    v_slc = v_s.reshape(B, n_slc, SLC_BLOCK, G, dh).transpose(0, 3, 1, 2, 4)
    gather = jax.vmap(jax.vmap(lambda kb, ix: kb[ix]))

    pad = ((0, 0), (WINDOW, 0), (0, 0), (0, 0))
    kw_pad, vw_pad = jnp.pad(k_w, pad), jnp.pad(v_w, pad)

    nqb = T // Q_BLOCK
    qb = q.reshape(B, nqb, Q_BLOCK, G, Hg, dh).transpose(1, 0, 3, 4, 2, 5)
    gb = jax.nn.sigmoid(gate_logits).reshape(B, nqb, Q_BLOCK, G, Hg, 3).transpose(1, 0, 3, 4, 2, 5)
    j_idx = jnp.arange(n_slc)

    def block_fn(args):
        qi, gi, blk = args
        t = blk * Q_BLOCK + jnp.arange(Q_BLOCK)
        dist_c = (t[:, None] - cmp_end[None, :]).astype(jnp.float32)
        valid_c = dist_c >= 0
        s_c = jnp.einsum('bghtd,bngd->bghtn', qi, k_cmp) * scale - slopes[None, :, :, None, None] * dist_c
        p_c = jax.nn.softmax(jnp.where(valid_c, s_c, NEG), axis=-1) * valid_c
        o_c = jnp.einsum('bghtn,bngd->bghtd', p_c, v_cmp)
        imp = jnp.einsum('bghtn,nj->bgtj', p_c, overlap)
        cur = t[:, None] // SLC_BLOCK
        forced = (j_idx[None] == 0) | (j_idx[None] == cur) | (j_idx[None] == cur - 1)
        imp = jnp.where(forced, FORCE, imp)
        imp = jnp.where(j_idx[None] * SLC_BLOCK <= t[:, None], imp, NEG)
        _, sel = lax.top_k(imp, top_n)
        k_sel = gather(k_slc, sel)
        v_sel = gather(v_slc, sel)
        pos_sel = sel[..., None] * SLC_BLOCK + jnp.arange(SLC_BLOCK)
        dist_s = (t[None, None, :, None, None] - pos_sel)[:, :, None].astype(jnp.float32)
        s_s = jnp.einsum('bghtd,bgtnsd->bghtns', qi, k_sel) * scale - slopes[None, :, :, None, None, None] * dist_s
        s_s = jnp.where(dist_s >= 0, s_s, NEG)
        sh = s_s.shape
        p_s = jax.nn.softmax(s_s.reshape(sh[:4] + (-1,)), axis=-1).reshape(sh)
        o_s = jnp.einsum('bghtns,bgtnsd->bghtd', p_s, v_sel)
        start = blk * Q_BLOCK
        k_win = lax.dynamic_slice_in_dim(kw_pad, start, WINDOW + Q_BLOCK, axis=1)
        v_win = lax.dynamic_slice_in_dim(vw_pad, start, WINDOW + Q_BLOCK, axis=1)
        s_pos = start - WINDOW + jnp.arange(WINDOW + Q_BLOCK)
        dist_w = t[:, None] - s_pos[None]
        valid_w = (dist_w >= 0) & (dist_w < WINDOW) & (s_pos[None] >= 0)
        s_w = jnp.einsum('bghtd,bsgd->bghts', qi, k_win) * scale - slopes[None, :, :, None, None] * dist_w.astype(jnp.float32)
        p_w = jax.nn.softmax(jnp.where(valid_w, s_w, NEG), axis=-1)
        o_w = jnp.einsum('bghts,bsgd->bghtd', p_w, v_win)
        return gi[..., 0:1] * o_c + gi[..., 1:2] * o_s + gi[..., 2:3] * o_w

    out = lax.map(block_fn, (qb, gb, jnp.arange(nqb)))
    return out.transpose(1, 0, 4, 2, 3, 5).reshape(B, T, NSA_WIDTH)


def setup_inputs(seed: int = 0) -> dict:
    key = jax.random.key(seed)
    ks = jax.random.split(key, 24)
    n = lambda k, shape, s: jax.random.normal(k, shape, jnp.float32) * s
    D = D_MODEL
    return {
        "x": n(ks[0], (BATCH, SEQ, D), 1.0),
        "c": n(ks[1], (BATCH, D), 1.0),
        "w_ada": n(ks[2], (DEPTH, D, 6 * D), D ** -0.5),
        "b_ada": n(ks[3], (DEPTH, 6 * D), 0.02),
        "w_in": n(ks[4], (DEPTH, D, IN_COLS), D ** -0.5),
        "hg_lb_logits": n(ks[5], (DEPTH + 1, HG_WIDTH), 1.0),
        "hg_norm_g": 1.0 + n(ks[6], (DEPTH, HG_WIDTH), 0.02),
        "cmp_pos_k": n(ks[7], (DEPTH, CMP_BLOCK, NSA_HEAD_DIM), 0.1),
        "cmp_w1_k": n(ks[8], (DEPTH, CMP_BLOCK * NSA_HEAD_DIM, CMP_HIDDEN), (CMP_BLOCK * NSA_HEAD_DIM) ** -0.5),
        "cmp_w2_k": n(ks[9], (DEPTH, CMP_HIDDEN, NSA_HEAD_DIM), CMP_HIDDEN ** -0.5),
        "cmp_pos_v": n(ks[10], (DEPTH, CMP_BLOCK, NSA_HEAD_DIM), 0.1),
        "cmp_w1_v": n(ks[11], (DEPTH, CMP_BLOCK * NSA_HEAD_DIM, CMP_HIDDEN), (CMP_BLOCK * NSA_HEAD_DIM) ** -0.5),
        "cmp_w2_v": n(ks[12], (DEPTH, CMP_HIDDEN, NSA_HEAD_DIM), CMP_HIDDEN ** -0.5),
        "w_out": n(ks[13], (DEPTH, D, D), D ** -0.5 * BETA),
        "ln1_g": 1.0 + n(ks[14], (DEPTH, D), 0.02),
        "ln1_b": n(ks[15], (DEPTH, D), 0.02),
        "ffn_w1": n(ks[16], (DEPTH, D, D_FF), D ** -0.5),
        "ffn_w3": n(ks[17], (DEPTH, D, D_FF), D ** -0.5),
        "ffn_w2": n(ks[18], (DEPTH, D_FF, D), D_FF ** -0.5 * BETA),
        "ln2_g": 1.0 + n(ks[19], (DEPTH, D), 0.02),
        "ln2_b": n(ks[20], (DEPTH, D), 0.02),
    }


def reference(x, c, w_ada, b_ada, w_in, hg_lb_logits, hg_norm_g,
              cmp_pos_k, cmp_w1_k, cmp_w2_k, cmp_pos_v, cmp_w1_v, cmp_w2_v,
              w_out, ln1_g, ln1_b, ffn_w1, ffn_w3, ffn_w2, ln2_g, ln2_b):
    f32 = jnp.float32
    lower_bounds = jnp.cumsum(jax.nn.softmax(hg_lb_logits.astype(f32), axis=0), axis=0)
    offs = np.cumsum(IN_SIZES)[:-1].tolist()
    for l in range(DEPTH):
        ada = jax.nn.silu(c) @ w_ada[l] + b_ada[l]
        sh1, sc1, g1, sh2, sc2, g2 = jnp.split(ada[:, None, :], 6, axis=-1)
        h = x * (1.0 + sc1) + sh1
        proj = (h @ w_in[l]).astype(f32)
        (hq, hf, hi, hg, nq, nkc, nvc, nks, nvs, nkw, nvw, ngate) = jnp.split(proj, offs, axis=-1)
        y_hg = hgrn2_mixer(hq, hf, hi, hg, lower_bounds[l], hg_norm_g[l].astype(f32))
        y_nsa = nsa_mixer(nq, nkc, nvc, nks, nvs, nkw, nvw, ngate,
                          cmp_pos_k[l].astype(f32), cmp_w1_k[l].astype(f32), cmp_w2_k[l].astype(f32),
                          cmp_pos_v[l].astype(f32), cmp_w1_v[l].astype(f32), cmp_w2_v[l].astype(f32))
        mix = jnp.concatenate([y_hg, y_nsa], axis=-1).astype(x.dtype) @ w_out[l]
        x = layer_norm(ALPHA * x + g1 * mix, ln1_g[l], ln1_b[l])
        h = x * (1.0 + sc2) + sh2
        ffn = (jax.nn.silu(h @ ffn_w1[l]) * (h @ ffn_w3[l])) @ ffn_w2[l]
        x = layer_norm(ALPHA * x + g2 * ffn, ln2_g[l], ln2_b[l])
    return x
```

```cpp
#include <hip/hip_runtime.h>
#include <cstdio>
#include <cstdint>
namespace pg8 {
#define PG8_LAS __attribute__((address_space(3)))
typedef unsigned short bf16_t;
typedef short bf16x8 __attribute__((ext_vector_type(8)));
typedef float f32x4 __attribute__((ext_vector_type(4)));
typedef unsigned u32x4 __attribute__((ext_vector_type(4)));
constexpr int BM = 256, BK = 64, HALF = 128, HTB = HALF * BK * 2  , STAGE_BYTES = 8 * HTB, NXCD = 8, WGM = 8;

__host__ __device__ __forceinline__ int lds_byte(int r, int c) { const int st = (r >> 4) * 2 + (c >> 5), rr = r & 15, cc = c & 31, ob = rr * 64 + cc * 2; return st * 1024 + (ob ^ (((ob >> 9) & 1) << 5)); }
__host__ __device__ __forceinline__ void stage_rc(int b, int& R, int& C) { const int st = b / 1024, sb = b % 1024, swz = sb ^ (((sb >> 9) & 1) << 5); R = (st >> 1) * 16 + swz / 64; C = (st & 1) * 32 + (swz % 64) / 2; }
__host__ __device__ __forceinline__ int perm32(int rho) { const int n = rho >> 4, i = rho & 15; return 8 * (i >> 2) + 4 * n + (i & 3); }

struct Unit { int pm, pn; };
struct Gemm { const bf16_t* A; const bf16_t* Bt; int M, N, K; };

struct StaticOrder {
    int nM, nN, nwg, G, c;
    __host__ __device__ void init(int M, int N, int G_, int c_) { nM = M / BM; nN = N / BM; nwg = nM * nN; G = G_; c = c_; }
    __host__ __device__ bool next(int i, Unit& u) const {
        const long L = (long)i * G + c; if (L >= nwg) return false;
        int wgid = (int)L; { const int q = nwg / NXCD, r = nwg % NXCD, xcd = wgid % NXCD, off = wgid / NXCD; wgid = (xcd < r ? xcd * (q + 1) : r * (q + 1) + (xcd - r) * q) + off; }
        const int nig = WGM * nN, gid = wgid / nig, fm = gid * WGM, gsz = (nM - fm) < WGM ? (nM - fm) : WGM;
        u.pm = fm + ((wgid % nig) % gsz); u.pn = (wgid % nig) / gsz; return true;
    }
    __device__ __forceinline__ void a_ready(const Unit&) const {}
    __device__ __forceinline__ void done(const Unit&) const {}
};

__device__ __forceinline__ unsigned cvt_pk_bf16(float lo, float hi) { unsigned r; asm volatile("v_cvt_pk_bf16_f32 %0, %1, %2" : "=v"(r) : "v"(lo), "v"(hi)); return r; }
typedef unsigned u32x2 __attribute__((ext_vector_type(2)));
__device__ __forceinline__ float fast_sigmoid(float x) { return __builtin_amdgcn_rcpf(1.0f + __expf(-x)); }
__device__ __forceinline__ float silu_f(float x) { return x * fast_sigmoid(x); }

struct EpiF32 {
    static constexpr bool PERM = false, AFTER_DRAIN = false;
    float* O; int ldc;
    __device__ __forceinline__ void operator()(const f32x4 (&acc)[2][2][4][2], const Unit& u, int wr, int wc, int fr, int fq) const {
        const int row0 = u.pm * BM + wr * 64 + fr, col0 = u.pn * BM + wc * 32 + 4 * fq;
#pragma unroll
        for (int ai = 0; ai < 2; ++ai)
#pragma unroll
            for (int m = 0; m < 4; ++m) { float* rowp = O + (size_t)(row0 + ai * HALF + m * 16) * ldc + col0;
#pragma unroll
                for (int bj = 0; bj < 2; ++bj)
#pragma unroll
                    for (int n = 0; n < 2; ++n) *(f32x4*)(rowp + bj * HALF + n * 16) = acc[ai][bj][m][n]; }
    }
};
struct EpiSwiGLU {
    static constexpr bool PERM = true, AFTER_DRAIN = false;
    bf16_t* U; int ldc;
    __device__ __forceinline__ void operator()(const f32x4 (&acc)[2][2][4][2], const Unit& u, int wr, int wc, int fr, int fq) const {
        const int row0 = u.pm * BM + wr * 64 + fr, col0 = u.pn * HALF + wc * 32 + 8 * fq;
#pragma unroll
        for (int ai = 0; ai < 2; ++ai)
#pragma unroll
            for (int m = 0; m < 4; ++m) { bf16_t* rowp = U + (size_t)(row0 + ai * HALF + m * 16) * ldc + col0;
                const f32x4 a0 = acc[ai][0][m][0], a1 = acc[ai][0][m][1], b0 = acc[ai][1][m][0], b1 = acc[ai][1][m][1];
                u32x4 w;
                w.x = cvt_pk_bf16(silu_f(a0[0]) * b0[0], silu_f(a0[1]) * b0[1]); w.y = cvt_pk_bf16(silu_f(a0[2]) * b0[2], silu_f(a0[3]) * b0[3]);
                w.z = cvt_pk_bf16(silu_f(a1[0]) * b1[0], silu_f(a1[1]) * b1[1]); w.w = cvt_pk_bf16(silu_f(a1[2]) * b1[2], silu_f(a1[3]) * b1[3]);
                *(u32x4*)rowp = w; }
    }
};
struct EpiProj {
    static constexpr bool PERM = true, AFTER_DRAIN = false;
    bf16_t *QH, *VH, *SG, *NQ, *KV; float *GH, *GATE; const float* lbl;
    __device__ __forceinline__ void operator()(const f32x4 (&acc)[2][2][4][2], const Unit& u, int wr, int wc, int fr, int fq) const {
        const int pn = u.pn; const int row0 = u.pm * BM + wr * 64 + fr; const int ch = wc * 32 + 8 * fq;
        if (pn < 2 || (pn >= 4 && pn < 10)) {
            bf16_t* base = pn < 2 ? QH : (pn < 6 ? VH : (pn < 8 ? SG : NQ)); const int mode = pn < 2 ? 1 : ((pn >= 6 && pn < 8) ? 2 : 0); const int cb = (pn & 1) * BM + ch;
#pragma unroll
            for (int ai = 0; ai < 2; ++ai)
#pragma unroll
                for (int m = 0; m < 4; ++m) { bf16_t* rowp = base + (size_t)(row0 + ai * HALF + m * 16) * 512 + cb;
#pragma unroll
                    for (int bj = 0; bj < 2; ++bj) { f32x4 v0 = acc[ai][bj][m][0], v1 = acc[ai][bj][m][1];
                        if (mode == 1) { for (int e = 0; e < 4; ++e) { v0[e] = silu_f(v0[e]); v1[e] = silu_f(v1[e]); } }
                        else if (mode == 2) { for (int e = 0; e < 4; ++e) { v0[e] = fast_sigmoid(v0[e]); v1[e] = fast_sigmoid(v1[e]); } }
                        u32x4 w; w.x = cvt_pk_bf16(v0[0], v0[1]); w.y = cvt_pk_bf16(v0[2], v0[3]); w.z = cvt_pk_bf16(v1[0], v1[1]); w.w = cvt_pk_bf16(v1[2], v1[3]);
                        *(u32x4*)(rowp + bj * HALF) = w; } }
        } else if (pn < 4) {
            const int cb = (pn & 1) * BM + ch;
            float lb[2][8];
#pragma unroll
            for (int bj = 0; bj < 2; ++bj)
#pragma unroll
                for (int e = 0; e < 8; ++e) { const int c = cb + bj * HALF + e; lb[bj][e] = fast_sigmoid(lbl[c] - lbl[512 + c]); }
#pragma unroll
            for (int ai = 0; ai < 2; ++ai)
#pragma unroll
                for (int m = 0; m < 4; ++m) { float* rowp = GH + (size_t)(row0 + ai * HALF + m * 16) * 512 + cb;
#pragma unroll
                    for (int bj = 0; bj < 2; ++bj) { f32x4 v0 = acc[ai][bj][m][0], v1 = acc[ai][bj][m][1];
#pragma unroll
                        for (int e = 0; e < 4; ++e) { v0[e] = __logf(lb[bj][e] + (1.0f - lb[bj][e]) * fast_sigmoid(v0[e])); v1[e] = __logf(lb[bj][4 + e] + (1.0f - lb[bj][4 + e]) * fast_sigmoid(v1[e])); }
                        *(f32x4*)(rowp + bj * HALF) = v0; *(f32x4*)(rowp + bj * HALF + 4) = v1; } }
        } else if (pn < 13) {
#pragma unroll
            for (int ai = 0; ai < 2; ++ai)
#pragma unroll
                for (int m = 0; m < 4; ++m) { const int row = row0 + ai * HALF + m * 16; const int b = row >> 12, t = row & 4095;
#pragma unroll
                    for (int bj = 0; bj < 2; ++bj) { const f32x4 v0 = acc[ai][bj][m][0], v1 = acc[ai][bj][m][1];
                        bf16_t* p = KV + ((size_t)((pn - 10) * 2 + bj) * 8 + (size_t)(b * 2 + (ch >> 6))) * (4096 * 64) + (size_t)t * 64 + (ch & 63);
                        u32x4 w; w.x = cvt_pk_bf16(v0[0], v0[1]); w.y = cvt_pk_bf16(v0[2], v0[3]); w.z = cvt_pk_bf16(v1[0], v1[1]); w.w = cvt_pk_bf16(v1[2], v1[3]);
                        *(u32x4*)p = w; } }
        } else {
            if (ch < 24) {
#pragma unroll
                for (int ai = 0; ai < 2; ++ai)
#pragma unroll
                    for (int m = 0; m < 4; ++m) { float* rowp = GATE + (size_t)(row0 + ai * HALF + m * 16) * 32 + ch; f32x4 v0 = acc[ai][0][m][0], v1 = acc[ai][0][m][1];
#pragma unroll
                        for (int e = 0; e < 4; ++e) { v0[e] = fast_sigmoid(v0[e]); v1[e] = fast_sigmoid(v1[e]); }
                        *(f32x4*)rowp = v0; *(f32x4*)(rowp + 4) = v1; }
            }
        }
    }
};
template <class Epi, class Sched, bool ALIGN_EPI = false, bool SP2 = false>
__device__ __forceinline__ void gemm_phase(PG8_LAS unsigned char* lds, const Gemm g, const Sched& S, const Epi& E) {
    const int tid = threadIdx.x, wid = __builtin_amdgcn_readfirstlane(tid >> 6), lane = tid & 63, wr = wid >> 2, wc = wid & 3, fr = lane & 15, fq = lane >> 4;
    const int K = g.K, nt = K / BK;
    unsigned voffA[2], voffB[2];
#pragma unroll
    for (int i = 0; i < 2; ++i) { int R, C; stage_rc(tid * 16 + i * 8192, R, C); const int Rb = Epi::PERM ? ((R & ~31) + perm32(R & 31)) : R;
        voffA[i] = (unsigned)(R * K + C) * 2u; voffB[i] = (unsigned)(Rb * K + C) * 2u; }
    const size_t kstep = (size_t)(BK * 2);
    const size_t hstep = (size_t)HALF * K * 2;
    const size_t tstep = 2 * hstep;
    const unsigned ldsw = (unsigned)wid * 1024u;
    const int aoff = lds_byte(wr * 64 + fr, fq * 8), boff = lds_byte(wc * 32 + fr, fq * 8);
#define PG8_SA(b, h) (((b) * 2 + (h)) * HTB)
#define PG8_SB(b, h) ((4 + (b) * 2 + (h)) * HTB)
#define PG8_STAGE(bufoff, gbase, voff) do { _Pragma("unroll") for (int _i = 0; _i < 2; ++_i) \
        __builtin_amdgcn_global_load_lds((const unsigned*)((const char*)(gbase) + (voff)[_i]), (PG8_LAS unsigned*)(lds + (bufoff) + ldsw + _i * 8192), 16, 0, 0); } while (0)
#define PG8_LDA(dst, b, h) do { _Pragma("unroll") for (int m = 0; m < 4; ++m) _Pragma("unroll") for (int k = 0; k < 2; ++k) dst[m][k] = *(const PG8_LAS bf16x8*)(lds + PG8_SA(b, h) + aoff + m * 2048 + k * 1024); } while (0)
#define PG8_LDB(dst, b, h) do { _Pragma("unroll") for (int n = 0; n < 2; ++n) _Pragma("unroll") for (int k = 0; k < 2; ++k) dst[n][k] = *(const PG8_LAS bf16x8*)(lds + PG8_SB(b, h) + boff + n * 2048 + k * 1024); } while (0)
#define PG8_MMA(ai, bj, At, Bt) do { __builtin_amdgcn_s_setprio(1); _Pragma("unroll") for (int m = 0; m < 4; ++m) _Pragma("unroll") for (int n = 0; n < 2; ++n) _Pragma("unroll") for (int k = 0; k < 2; ++k) \
        acc[ai][bj][m][n] = __builtin_amdgcn_mfma_f32_16x16x32_bf16(Bt[n][k], At[m][k], acc[ai][bj][m][n], 0, 0, 0); __builtin_amdgcn_s_setprio(0); } while (0)
#define PG8_WAIT_V(n) asm volatile("s_waitcnt vmcnt(" #n ")" ::: "memory")
#define PG8_WAIT_L(n) asm volatile("s_waitcnt lgkmcnt(" #n ")" ::: "memory")
#define PG8_BAR __builtin_amdgcn_s_barrier()
#define PG8_SCHED __builtin_amdgcn_sched_barrier(0)
    Unit cur, nxt; int ui = 0;
    if (!S.next(0, cur)) return;
    f32x4 acc[2][2][4][2];
#pragma unroll
    for (int a = 0; a < 2; ++a)
#pragma unroll
        for (int b = 0; b < 2; ++b)
#pragma unroll
            for (int m = 0; m < 4; ++m)
#pragma unroll
                for (int n = 0; n < 2; ++n) acc[a][b][m][n] = (f32x4){0.f, 0.f, 0.f, 0.f};
    bf16x8 At[4][2], B0[2][2], B1[2][2];
    const char* cA = (const char*)g.A + (size_t)cur.pm * tstep; const char* cB = (const char*)g.Bt + (size_t)cur.pn * tstep;
    S.a_ready(cur);
    if constexpr (SP2) {
        PG8_STAGE(PG8_SB(0, 0), cB, voffB); PG8_STAGE(PG8_SB(0, 1), cB + hstep, voffB); PG8_STAGE(PG8_SA(0, 0), cA, voffA); PG8_STAGE(PG8_SA(0, 1), cA + hstep, voffA);
        if (wr == 1) PG8_BAR;
        PG8_WAIT_V(2); PG8_BAR;
        PG8_STAGE(PG8_SB(1, 0), cB + kstep, voffB); PG8_STAGE(PG8_SA(1, 0), cA + kstep, voffA); PG8_STAGE(PG8_SB(1, 1), cB + hstep + kstep, voffB);
        PG8_WAIT_V(6); PG8_BAR;
    } else {
        PG8_STAGE(PG8_SB(0, 0), cB, voffB); PG8_STAGE(PG8_SA(0, 0), cA, voffA); PG8_STAGE(PG8_SB(0, 1), cB + hstep, voffB); PG8_STAGE(PG8_SA(0, 1), cA + hstep, voffA);
        if (wr == 1) PG8_BAR;
        PG8_WAIT_V(4); PG8_BAR;
        PG8_STAGE(PG8_SB(1, 0), cB + kstep, voffB); PG8_STAGE(PG8_SA(1, 0), cA + kstep, voffA); PG8_STAGE(PG8_SB(1, 1), cB + hstep + kstep, voffB);
        PG8_WAIT_V(6); PG8_BAR;
    }
    for (;;) {
        const bool has_next = S.next(ui + 1, nxt);
        const char* nA = has_next ? (const char*)g.A + (size_t)nxt.pm * tstep : cA; const char* nB = has_next ? (const char*)g.Bt + (size_t)nxt.pn * tstep : cB;
        for (int t = 0; t < nt; t += 2) {
            const bool last = (t == nt - 2);
            const char* a1 = cA + (size_t)(t + 1) * kstep;
            const char* a2 = last ? nA : cA + (size_t)(t + 2) * kstep; const char* b2 = last ? nB : cB + (size_t)(t + 2) * kstep;
            const char* a3 = a2 + kstep; const char* b3 = b2 + kstep;
            if (last && has_next) S.a_ready(nxt);
            if constexpr (SP2) {
            PG8_LDB(B0, 0, 0); PG8_LDB(B1, 0, 1); PG8_SCHED; PG8_LDA(At, 0, 0); PG8_STAGE(PG8_SA(1, 1), a1 + hstep, voffA);
            PG8_WAIT_V(8); PG8_WAIT_L(0); PG8_BAR; PG8_MMA(0, 0, At, B0); PG8_MMA(0, 1, At, B1); PG8_BAR; PG8_SCHED;
            PG8_LDA(At, 0, 1); PG8_STAGE(PG8_SB(0, 0), b2, voffB); PG8_STAGE(PG8_SB(0, 1), b2 + hstep, voffB); PG8_STAGE(PG8_SA(0, 0), a2, voffA);
            PG8_WAIT_V(8); PG8_WAIT_L(0); PG8_BAR; PG8_MMA(1, 0, At, B0); PG8_MMA(1, 1, At, B1); PG8_BAR; PG8_SCHED;
            PG8_LDB(B0, 1, 0); PG8_LDB(B1, 1, 1); PG8_SCHED; PG8_LDA(At, 1, 0); PG8_STAGE(PG8_SA(0, 1), a2 + hstep, voffA);
            PG8_WAIT_V(8); PG8_WAIT_L(0); PG8_BAR; PG8_MMA(0, 0, At, B0); PG8_MMA(0, 1, At, B1); PG8_BAR; PG8_SCHED;
            PG8_LDA(At, 1, 1); PG8_STAGE(PG8_SB(1, 0), b3, voffB); PG8_STAGE(PG8_SB(1, 1), b3 + hstep, voffB); PG8_STAGE(PG8_SA(1, 0), a3, voffA);
            PG8_WAIT_V(8); PG8_WAIT_L(0); PG8_BAR; PG8_MMA(1, 0, At, B0); PG8_MMA(1, 1, At, B1); PG8_BAR; PG8_SCHED;
            } else {
            PG8_LDB(B0, 0, 0); PG8_SCHED; PG8_LDA(At, 0, 0); PG8_STAGE(PG8_SA(1, 1), a1 + hstep, voffA);
            PG8_WAIT_L(8); PG8_BAR; PG8_WAIT_L(0); PG8_MMA(0, 0, At, B0); PG8_BAR; PG8_SCHED;
            PG8_LDB(B1, 0, 1); PG8_STAGE(PG8_SB(0, 0), b2, voffB);
            PG8_BAR; PG8_WAIT_L(0); PG8_MMA(0, 1, At, B1); PG8_BAR;
            PG8_LDA(At, 0, 1); PG8_STAGE(PG8_SA(0, 0), a2, voffA);
            PG8_BAR; PG8_WAIT_L(0); PG8_MMA(1, 0, At, B0); PG8_BAR; PG8_SCHED;
            PG8_STAGE(PG8_SB(0, 1), b2 + hstep, voffB);
            PG8_WAIT_V(6); PG8_BAR; PG8_MMA(1, 1, At, B1); PG8_BAR;
            PG8_LDB(B0, 1, 0); PG8_SCHED; PG8_LDA(At, 1, 0); PG8_STAGE(PG8_SA(0, 1), a2 + hstep, voffA);
            PG8_WAIT_L(8); PG8_BAR; PG8_WAIT_L(0); PG8_MMA(0, 0, At, B0); PG8_BAR; PG8_SCHED;
            PG8_LDB(B1, 1, 1); PG8_STAGE(PG8_SB(1, 0), b3, voffB);
            PG8_BAR; PG8_WAIT_L(0); PG8_MMA(0, 1, At, B1); PG8_BAR;
            PG8_LDA(At, 1, 1); PG8_STAGE(PG8_SA(1, 0), a3, voffA);
            PG8_BAR; PG8_WAIT_L(0); PG8_MMA(1, 0, At, B0); PG8_BAR; PG8_SCHED;
            PG8_STAGE(PG8_SB(1, 1), b3 + hstep, voffB);
            PG8_WAIT_V(6); PG8_BAR; PG8_MMA(1, 1, At, B1); PG8_BAR;
            }
        }
        if constexpr (ALIGN_EPI) { if (wr == 0) PG8_BAR; }
        if constexpr (!Epi::AFTER_DRAIN) { E(acc, cur, wr, wc, fr, fq); S.done(cur); }
        if (!has_next) break;
#pragma unroll
        for (int a = 0; a < 2; ++a)
#pragma unroll
            for (int b = 0; b < 2; ++b)
#pragma unroll
                for (int m = 0; m < 4; ++m)
#pragma unroll
                    for (int n = 0; n < 2; ++n) acc[a][b][m][n] = (f32x4){0.f, 0.f, 0.f, 0.f};
        cur = nxt; cA = nA; cB = nB; ++ui;
        if constexpr (ALIGN_EPI) { if (wr == 1) PG8_BAR; }
    }
    PG8_WAIT_V(0);
    if constexpr (!ALIGN_EPI) { if (wr == 0) PG8_BAR; }
    PG8_BAR;
    if constexpr (Epi::AFTER_DRAIN) { E.fused(acc, cur, wr, wc, fr, fq, lds, wid, lane); S.done(cur); }
#undef PG8_SA
#undef PG8_SB
#undef PG8_STAGE
#undef PG8_LDA
#undef PG8_LDB
#undef PG8_MMA
#undef PG8_WAIT_V
#undef PG8_WAIT_L
#undef PG8_BAR
#undef PG8_SCHED
}
}

constexpr int NWAVES = 8;
constexpr int NB = 4, T = 4096, D = 1024, M = NB * T, NIN = 3352, NINP = 3584, FF = 2816, NUP = 2 * FF;
constexpr float LN_EPS = 1e-5f, RMS_EPS = 1e-6f, ALPHA = 1.189207115002721f;
constexpr float NEGF = -1e30f;
constexpr size_t MiB = 1u << 20;
constexpr size_t WS_CTL = 0, CTL_ZERO_BYTES = 1 * MiB;
constexpr size_t WS_ADAP = 1 * MiB;
constexpr size_t WS_ADA = 2 * MiB + 512 * 1024;
constexpr size_t WS_KCMP = 2 * MiB + 768 * 1024;
constexpr size_t WS_VCMP = 3 * MiB + 256 * 1024;
constexpr size_t WS_WIN = 4 * MiB, WS_WO = 11 * MiB, WS_WUP = 13 * MiB, WS_WDN = 24 * MiB;
constexpr size_t WS_XN = 32 * MiB;
constexpr size_t WS_Y = 64 * MiB;
constexpr size_t WS_QH = 96 * MiB, WS_GH = 112 * MiB, WS_VH = 144 * MiB, WS_SG = 160 * MiB, WS_NQ = 176 * MiB, WS_KV = 192 * MiB, WS_GATE = 216 * MiB;
constexpr size_t WS_U = 96 * MiB;
constexpr size_t WS_FFN = 184 * MiB;
constexpr size_t WS_END = 256 * MiB;
constexpr int CW_BAR = 4096;
constexpr int RING_BYTES = 131072, LDSCTL_OFF = RING_BYTES, MISC_OFF = LDSCTL_OFF + 320, LDS_BYTES = 147456;

#define GAS __attribute__((address_space(1)))
#define LAS __attribute__((address_space(3)))
typedef unsigned short bf16;
typedef unsigned v4u __attribute__((ext_vector_type(4)));
typedef float f32x4 __attribute__((ext_vector_type(4)));
#define LDS_WAIT() asm volatile("s_waitcnt lgkmcnt(0)" ::: "memory")
#define VM_WAIT() asm volatile("s_waitcnt vmcnt(0)" ::: "memory")
__device__ __forceinline__ unsigned f2bf(float f) { unsigned u = __builtin_bit_cast(unsigned, f); return (u + 0x7fffu + ((u >> 16) & 1u)) >> 16; }
__device__ __forceinline__ unsigned pk2(float lo, float hi) { return f2bf(lo) | (f2bf(hi) << 16); }
__device__ __forceinline__ float bf2f(unsigned u) { return __builtin_bit_cast(float, u << 16); }
__device__ __forceinline__ float wave_sum(float v) {
#pragma unroll
    for (int o = 1; o < 64; o <<= 1) v += __shfl_xor(v, o);
    return v;
}
__device__ __forceinline__ float wave_max(float v) {
#pragma unroll
    for (int o = 1; o < 64; o <<= 1) v = fmaxf(v, __shfl_xor(v, o));
    return v;
}
#define XB_TMO      128
#define XB_XCNT(j)  (256  + 64 * (j))
#define XB_XSUB(j)  (1280 + 64 * (j))
#define XB_XGEN(j)  (2304 + 64 * (j))
#define XB_TOP      3328
#define XB_TOPGEN   3392
#define XCD_BAR_WORDS 3456
#define XB_SPIN_CAP (1u << 18)

__device__ __forceinline__ unsigned xb_ld(unsigned* p)              { return __hip_atomic_load(p, __ATOMIC_RELAXED, __HIP_MEMORY_SCOPE_AGENT); }
__device__ __forceinline__ unsigned xb_add(unsigned* p, unsigned v) { return __hip_atomic_fetch_add(p, v, __ATOMIC_RELAXED, __HIP_MEMORY_SCOPE_AGENT); }
__device__ __forceinline__ unsigned xb_xcc_id() { return (unsigned)__builtin_amdgcn_s_getreg((3 << 11) | 20) & 0xFu; }
#define XB_SPIN(cond, bar) do { unsigned _sp = 0; while (cond) { __builtin_amdgcn_s_sleep(1); \
    if ((++_sp & 255u) == 0u) { if (xb_ld(&(bar)[XB_TMO])) break; if (_sp > XB_SPIN_CAP) { atomicAdd(&(bar)[XB_TMO], 1u); break; } } } } while (0)

struct XcdBarrier {
    unsigned* bar; unsigned x;
    volatile LAS unsigned* st;
};

__device__ __forceinline__ XcdBarrier xcd_barrier_post(unsigned* bar, volatile LAS unsigned* st) {
    XcdBarrier b; b.bar = bar; b.x = xb_xcc_id(); b.st = st;
    if (threadIdx.x == 0) (void)xb_add(&bar[XB_XCNT(b.x)], 1u);
    return b;
}
__device__ __forceinline__ void xcd_barrier_complete(unsigned* bar, unsigned x, unsigned& nloc, unsigned& nx) {
    const unsigned G = gridDim.x * gridDim.y * gridDim.z;
    unsigned sum, cnt, mine, sp = 0u;
    for (;;) {
        sum = 0u; cnt = 0u; mine = 0u;
#pragma unroll
        for (unsigned j = 0; j < 16; ++j) { const unsigned c = xb_ld(&bar[XB_XCNT(j)]); sum += c; cnt += (c > 0u) ? 1u : 0u; mine = (j == x) ? c : mine; }
        if (sum == G) break;
        __builtin_amdgcn_s_sleep(1);
        if ((++sp & 255u) == 0u) { if (xb_ld(&bar[XB_TMO])) break; if (sp > XB_SPIN_CAP) { atomicAdd(&bar[XB_TMO], 1u); break; } }
    }
    nloc = mine > 0u ? mine : 1u; nx = cnt > 0u ? cnt : 1u;
}

__device__ __forceinline__ void xcd_barrier(const XcdBarrier& b) {
    asm volatile("s_waitcnt vmcnt(0)" ::: "memory");
    __syncthreads();
    if (threadIdx.x == 0) {
        unsigned* bar = b.bar;
        __builtin_amdgcn_s_waitcnt(0);
        unsigned nloc = b.st[0], nx = b.st[1];
        if (nloc == 0u) { xcd_barrier_complete(bar, b.x, nloc, nx); b.st[0] = nloc; b.st[1] = nx; }
        const unsigned old = xb_add(&bar[XB_XSUB(b.x)], 1u);
        const unsigned gen = old / nloc;
        if (old + 1u == (gen + 1u) * nloc) {
            __builtin_amdgcn_fence(__ATOMIC_RELEASE, "agent");
            asm volatile("s_waitcnt vmcnt(0)" ::: "memory");
            const unsigned og = xb_add(&bar[XB_TOP], 1u);
            const unsigned tg = og / nx;
            if (og + 1u == (tg + 1u) * nx) xb_add(&bar[XB_TOPGEN], 1u);
            else XB_SPIN(xb_ld(&bar[XB_TOPGEN]) == tg, bar);
            __builtin_amdgcn_fence(__ATOMIC_ACQUIRE, "agent");
            xb_add(&bar[XB_XGEN(b.x)], 1u);
            asm volatile("s_waitcnt vmcnt(0)" ::: "memory");
        } else {
            XB_SPIN(xb_ld(&bar[XB_XGEN(b.x)]) == gen, bar);
            __builtin_amdgcn_fence(__ATOMIC_ACQUIRE, "agent");
            asm volatile("s_waitcnt vmcnt(0)" ::: "memory");
        }
    }
    __syncthreads();
}

__device__ __forceinline__ void transpose_item(const float* W, int K, int N, bf16* WT, int dst_row0, LAS float* scr, int k0, int n0, int lane) {
#pragma unroll 8
    for (int i = 0; i < 32; ++i) { const int kk = 2 * i + (lane >> 5); const int n = n0 + (lane & 31); scr[kk * 33 + (lane & 31)] = (n < N) ? W[(size_t)(k0 + kk) * N + n] : 0.f; }
    LDS_WAIT(); asm volatile("" ::: "memory");
    const int c = lane & 7;
#pragma unroll
    for (int j = 0; j < 4; ++j) { const int n = (lane >> 3) + 8 * j; const LAS float* s = scr + (8 * c) * 33 + n;
        v4u o; o.x = pk2(s[0 * 33], s[1 * 33]); o.y = pk2(s[2 * 33], s[3 * 33]); o.z = pk2(s[4 * 33], s[5 * 33]); o.w = pk2(s[6 * 33], s[7 * 33]);
        *(GAS v4u*)(WT + (size_t)(dst_row0 + n) * K + k0 + 8 * c) = o; }
    LDS_WAIT(); asm volatile("" ::: "memory");
}

struct Args { const float* in[21]; float* out; unsigned char* ws; };

__device__ __forceinline__ void dot4(const bf16* krow, const LAS float* qs, float (&s)[4]) {
    s[0] = s[1] = s[2] = s[3] = 0.f;
#pragma unroll 1
    for (int c = 0; c < 8; ++c) {
        asm volatile("" ::: "memory");
        const v4u kk = *(const GAS v4u*)(krow + 8 * c);
        float kf[8]; kf[0] = bf2f(kk.x & 0xffffu); kf[1] = bf2f(kk.x >> 16); kf[2] = bf2f(kk.y & 0xffffu); kf[3] = bf2f(kk.y >> 16);
        kf[4] = bf2f(kk.z & 0xffffu); kf[5] = bf2f(kk.z >> 16); kf[6] = bf2f(kk.w & 0xffffu); kf[7] = bf2f(kk.w >> 16);
#pragma unroll
        for (int h = 0; h < 4; ++h) { const f32x4 q0 = *(const LAS f32x4*)(qs + h * 64 + 8 * c), q1 = *(const LAS f32x4*)(qs + h * 64 + 8 * c + 4);
            s[h] += kf[0] * q0.x + kf[1] * q0.y + kf[2] * q0.z + kf[3] * q0.w + kf[4] * q1.x + kf[5] * q1.y + kf[6] * q1.z + kf[7] * q1.w; }
    }
}
template <int MODE>
__device__ __forceinline__ void nsa_branch_bf(const bf16* Kb, const bf16* Vb, unsigned long long mask, int t, int nvalid, const float (&slope)[4],
                                              LAS float* qs, LAS float* pb, LAS float* pc, int lane, float (&o)[4]) {
    float m[4], l[4];
#pragma unroll
    for (int h = 0; h < 4; ++h) { m[h] = NEGF; l[h] = 0.f; }
    for (unsigned long long mm = mask; mm; mm &= mm - 1) {
        const int j = __builtin_ctzll(mm); const int idx = j * 64 + lane;
        bool valid; float dist;
        if (MODE == 0) { valid = idx < nvalid; dist = (float)(t - (16 * idx + 31)); }
        else if (MODE == 1) { valid = idx <= t; dist = (float)(t - idx); }
        else { valid = (idx <= t) && (idx > t - 512); dist = (float)(t - idx); }
        float s[4]; dot4(Kb + (size_t)idx * 64, qs, s);
        if (valid) {
#pragma unroll
            for (int h = 0; h < 4; ++h) { const float sv = s[h] - slope[h] * dist; const float mn = fmaxf(m[h], sv); l[h] = l[h] * __expf(m[h] - mn) + __expf(sv - mn); m[h] = mn; }
        }
    }
#pragma unroll
    for (int h = 0; h < 4; ++h) { const float Mx = wave_max(m[h]); const float ls = wave_sum(l[h] * __expf(m[h] - Mx)); m[h] = Mx; l[h] = ls > 0.f ? 1.0f / ls : 0.f; o[h] = 0.f; }
    for (unsigned long long mm = mask; mm; mm &= mm - 1) {
        const int j = __builtin_ctzll(mm); const int idx = j * 64 + lane;
        bool valid; float dist;
        if (MODE == 0) { valid = idx < nvalid; dist = (float)(t - (16 * idx + 31)); }
        else if (MODE == 1) { valid = idx <= t; dist = (float)(t - idx); }
        else { valid = (idx <= t) && (idx > t - 512); dist = (float)(t - idx); }
        float s[4]; dot4(Kb + (size_t)idx * 64, qs, s);
        f32x4 p;
#pragma unroll
        for (int h = 0; h < 4; ++h) { const float sv = s[h] - slope[h] * dist; p[h] = valid ? __expf(sv - m[h]) * l[h] : 0.f; }
        *(LAS f32x4*)(pb + lane * 4) = p;
        if (MODE == 0) { pc[idx] = p[0]; pc[256 + idx] = p[1]; pc[512 + idx] = p[2]; pc[768 + idx] = p[3]; }
        LDS_WAIT(); asm volatile("" ::: "memory");
        const bf16* vp = Vb + (size_t)(j * 64) * 64 + lane;
#pragma unroll 8
        for (int key = 0; key < 64; ++key) { const f32x4 p4 = *(const LAS f32x4*)(pb + key * 4); const float v = bf2f(vp[key * 64]);
            o[0] += p4.x * v; o[1] += p4.y * v; o[2] += p4.z * v; o[3] += p4.w * v; }
        LDS_WAIT(); asm volatile("" ::: "memory");
    }
}

__global__ void __launch_bounds__(NWAVES * 64, 2) fwd_kernel(Args args) {
    extern __shared__ __attribute__((aligned(16))) unsigned char lds_raw[];
    LAS unsigned char* lds = (LAS unsigned char*)lds_raw;
    volatile LAS unsigned* MISC = (volatile LAS unsigned*)(lds + MISC_OFF);
    const int tid = threadIdx.x, lane = tid & 63, wave = __builtin_amdgcn_readfirstlane(tid >> 6);
    const int G = gridDim.x; const int bx = blockIdx.x; const int vcu = (G % 8 == 0) ? (bx % 8) * (G / 8) + bx / 8 : bx;
    unsigned char* ws = args.ws;
    unsigned* ctl = (unsigned*)(ws + WS_CTL);
    const float* x = args.in[0]; const float* cvec = args.in[1]; const float* w_ada = args.in[2]; const float* b_ada = args.in[3]; const float* w_in = args.in[4];
    const float* lbl = args.in[5]; const float* hg_norm_g = args.in[6]; const float* pos_k = args.in[7]; const float* w1_k = args.in[8]; const float* w2_k = args.in[9];
    const float* pos_v = args.in[10]; const float* w1_v = args.in[11]; const float* w2_v = args.in[12]; const float* w_out = args.in[13];
    const float* ln1_g = args.in[14]; const float* ln1_b = args.in[15]; const float* ffn_w1 = args.in[16]; const float* ffn_w3 = args.in[17]; const float* ffn_w2 = args.in[18];
    const float* ln2_g = args.in[19]; const float* ln2_b = args.in[20];
    float* out = args.out;
    float* ADAP = (float*)(ws + WS_ADAP); float* ADA = (float*)(ws + WS_ADA);
    bf16* Win_t = (bf16*)(ws + WS_WIN); bf16* Wo_t = (bf16*)(ws + WS_WO); bf16* Wup_t = (bf16*)(ws + WS_WUP); bf16* Wdn_t = (bf16*)(ws + WS_WDN);
    bf16* XN = (bf16*)(ws + WS_XN); bf16* Y = (bf16*)(ws + WS_Y);
    bf16* QH = (bf16*)(ws + WS_QH); float* GH = (float*)(ws + WS_GH); bf16* VH = (bf16*)(ws + WS_VH); bf16* SG = (bf16*)(ws + WS_SG); bf16* NQ = (bf16*)(ws + WS_NQ);
    bf16* KV = (bf16*)(ws + WS_KV); float* GATE = (float*)(ws + WS_GATE); bf16* U = (bf16*)(ws + WS_U); float* FFN = (float*)(ws + WS_FFN);

    for (int u = tid; u < (LDS_BYTES - LDSCTL_OFF) / 4; u += NWAVES * 64) ((LAS unsigned*)(lds + LDSCTL_OFF))[u] = 0u;
    __syncthreads();
    XcdBarrier bar = xcd_barrier_post(ctl + CW_BAR, MISC + 8);
    const int gw = vcu * NWAVES + wave, NGW = G * NWAVES;

    {
        LAS float* scr = (LAS float*)(lds + wave * 16384);
        constexpr int I_IN = 105 * 16, I_O = 32 * 16, I_1 = 88 * 16, I_2 = 32 * 44;
        constexpr int NITEMS = I_IN + I_O + 2 * I_1 + I_2;
        for (int it = gw; it < NITEMS; it += NGW) {
            int r = it;
            if (r < I_IN) { const int kb = r / 105, nb = r % 105; transpose_item(w_in, D, NIN, Win_t, 32 * nb, scr, 64 * kb, 32 * nb, lane); continue; } r -= I_IN;
            if (r < I_O) { const int kb = r / 32, nb = r % 32; transpose_item(w_out, D, D, Wo_t, 32 * nb, scr, 64 * kb, 32 * nb, lane); continue; } r -= I_O;
            if (r < I_1) { const int kb = r / 88, nb = r % 88; const int n0 = 32 * nb; transpose_item(ffn_w1, D, FF, Wup_t, 256 * (n0 >> 7) + (n0 & 127), scr, 64 * kb, n0, lane); continue; } r -= I_1;
            if (r < I_1) { const int kb = r / 88, nb = r % 88; const int n0 = 32 * nb; transpose_item(ffn_w3, D, FF, Wup_t, 256 * (n0 >> 7) + 128 + (n0 & 127), scr, 64 * kb, n0, lane); continue; } r -= I_1;
            { const int kb = r / 32, nb = r % 32; transpose_item(ffn_w2, FF, D, Wdn_t, 32 * nb, scr, 64 * kb, 32 * nb, lane); }
        }
        { const int gt = vcu * 512 + tid; constexpr int NZ = (NINP - 3360) * D * 2 / 16; v4u z; z.x = z.y = z.z = z.w = 0u;
          for (int i = gt; i < NZ; i += G * 512) ((GAS v4u*)(Win_t + (size_t)3360 * D))[i] = z; }
        { const int gt = vcu * 512 + tid;
          if (gt < 16 * 6144) { const int ks = gt / 6144, col = gt % 6144; float a0 = 0.f, a1 = 0.f, a2 = 0.f, a3 = 0.f;
            for (int k = ks * 64; k < ks * 64 + 64; ++k) { const float w = w_ada[(size_t)k * 6144 + col];
                const float c0 = cvec[k], c1 = cvec[D + k], c2 = cvec[2 * D + k], c3 = cvec[3 * D + k];
                a0 += pg8::silu_f(c0) * w; a1 += pg8::silu_f(c1) * w; a2 += pg8::silu_f(c2) * w; a3 += pg8::silu_f(c3) * w; }
            float* p = ADAP + (size_t)ks * 4 * 6144 + col; p[0] = a0; p[6144] = a1; p[2 * 6144] = a2; p[3 * 6144] = a3; } }
    }
    xcd_barrier(bar);

    {
        { const int gt = vcu * 512 + tid;
          if (gt < 4 * 6144) { const int col = gt % 6144; float a = b_ada[col];
            for (int ks = 0; ks < 16; ++ks) a += ADAP[(size_t)ks * 4 * 6144 + gt];
            ADA[gt] = a; } }
        LAS float* shs = (LAS float*)lds;
        const int b = (vcu * 64) >> 12;
        for (int i = tid; i < 2048; i += 512) { float a = b_ada[i];
            for (int ks = 0; ks < 16; ++ks) a += ADAP[(size_t)ks * 4 * 6144 + b * 6144 + i];
            shs[i] = a; }
        __syncthreads();
        for (int r = 0; r < 8; ++r) { const int row = vcu * 64 + wave * 8 + r;
            const GAS f32x4* xr = (const GAS f32x4*)(x + (size_t)row * D) + lane;
            GAS unsigned long long* o8 = (GAS unsigned long long*)(XN + (size_t)row * D) + lane;
#pragma unroll
            for (int j = 0; j < 4; ++j) { const f32x4 v = xr[64 * j]; const f32x4 sh = *(const LAS f32x4*)(shs + 4 * lane + 256 * j), sc = *(const LAS f32x4*)(shs + 1024 + 4 * lane + 256 * j);
                const f32x4 h = v * (sc + 1.0f) + sh;
                o8[64 * j] = (unsigned long long)pk2(h.x, h.y) | ((unsigned long long)pk2(h.z, h.w) << 32); } }
        __syncthreads();
    }
    xcd_barrier(bar);

    {
        pg8::Gemm g{XN, Win_t, M, NINP, D}; pg8::StaticOrder S; S.init(M, NINP, G, bx);
        pg8::EpiProj E{QH, VH, SG, NQ, KV, GH, GATE, lbl};
        pg8::gemm_phase<pg8::EpiProj, pg8::StaticOrder, true, true>(lds, g, S, E);
    }
    xcd_barrier(bar);

    if (vcu < 16) {
        const int b = vcu >> 2, h = vcu & 3; const int dv = tid >> 2, kq = tid & 3;
        LAS float* qf = (LAS float*)lds; LAS float* ff = qf + 32 * 144; LAS float* kk = ff + 32 * 144; LAS float* vv = kk + 32 * 144; LAS float* oo = vv + 32 * 128;
        float S[32];
#pragma unroll
        for (int i = 0; i < 32; ++i) S[i] = 0.f;
        for (int t0 = 0; t0 < T; t0 += 32) {
            for (int e = tid; e < 4096; e += 512) { const int tt = e >> 7, dk = e & 127; const size_t gi = (size_t)(b * T + t0 + tt) * 512 + h * 128 + dk;
                const float f = __expf(GH[gi]); const int off = tt * 144 + (dk >> 5) * 36 + (dk & 31);
                qf[off] = bf2f(QH[gi]); ff[off] = f; kk[off] = 1.0f - f; vv[tt * 128 + dk] = bf2f(VH[gi]); }
            __syncthreads();
            for (int tt = 0; tt < 32; ++tt) {
                const float v = vv[tt * 128 + dv]; float acc = 0.f; const int base = tt * 144 + kq * 36;
#pragma unroll
                for (int i4 = 0; i4 < 8; ++i4) { const f32x4 f4 = *(const LAS f32x4*)(ff + base + 4 * i4), k4 = *(const LAS f32x4*)(kk + base + 4 * i4), q4 = *(const LAS f32x4*)(qf + base + 4 * i4);
#pragma unroll
                    for (int e = 0; e < 4; ++e) { S[4 * i4 + e] = f4[e] * S[4 * i4 + e] + k4[e] * v; acc += q4[e] * S[4 * i4 + e]; } }
                acc += __shfl_xor(acc, 1); acc += __shfl_xor(acc, 2);
                if (kq == 0) oo[tt * 128 + dv] = acc;
            }
            __syncthreads();
#pragma unroll
            for (int r = 0; r < 4; ++r) { const int tt = 4 * wave + r; const float a = oo[tt * 128 + lane], c = oo[tt * 128 + 64 + lane];
                const float ss = wave_sum(a * a + c * c); const float rs = 1.0f / sqrtf(ss * (1.0f / 128.0f) + RMS_EPS);
                const size_t row = (size_t)(b * T + t0 + tt); const int col = h * 128 + lane;
                Y[row * D + col] = (bf16)f2bf(a * rs * hg_norm_g[col] * bf2f(SG[row * 512 + col]));
                Y[row * D + col + 64] = (bf16)f2bf(c * rs * hg_norm_g[col + 64] * bf2f(SG[row * 512 + col + 64])); }
            __syncthreads();
        }
    } else {
        LAS float* inb = (LAS float*)lds;
        LAS float* hid = inb + 2 * 144 * 64;
        const bf16* KC = KV; const bf16* VC = KV + (size_t)8 * T * 64;
        const int kind = __builtin_amdgcn_readfirstlane(tid >> 8), j = tid & 255;
        const float* w1 = kind ? w1_v : w1_k; const float* posp = kind ? pos_v : pos_k; const float* w2 = kind ? w2_v : w2_k;
        for (int unit = vcu - 16; unit < 256; unit += G - 16) {
            const int bg = unit >> 5, n0 = (unit & 31) * 8;
            for (int e = tid; e < 2 * 144 * 64; e += 512) { const int kd = e / (144 * 64), r = e % (144 * 64), tok = 16 * n0 + (r >> 6);
                const bf16* src = (kd ? VC : KC) + ((size_t)bg * T) * 64; inb[e] = tok < T ? bf2f(src[(size_t)tok * 64 + (r & 63)]) : 0.f; }
            __syncthreads();
            float acc[8];
#pragma unroll
            for (int q = 0; q < 8; ++q) acc[q] = 0.f;
            const LAS float* ib = inb + kind * 144 * 64;
            for (int i = 0; i < 2048; ++i) { const float w = w1[(size_t)i * 256 + j]; const float pz = posp[i];
#pragma unroll
                for (int q = 0; q < 8; ++q) acc[q] += (ib[q * 1024 + i] + pz) * w; }
#pragma unroll
            for (int q = 0; q < 8; ++q) { const float xv = acc[q]; const float gl = 0.5f * xv * (1.0f + tanhf(0.7978845608028654f * (xv + 0.044715f * xv * xv * xv))); hid[(kind * 8 + q) * 256 + j] = gl; }
            __syncthreads();
#pragma unroll
            for (int rep = 0; rep < 2; ++rep) { const int oidx = tid + 512 * rep; const int kd = oidx >> 9, q = (oidx >> 6) & 7, d = oidx & 63;
                const float* w2p = kd ? w2_v : w2_k; const LAS float* hp = hid + (kd * 8 + q) * 256; float a = 0.f;
                for (int jj = 0; jj < 256; ++jj) a += hp[jj] * w2p[jj * 64 + d];
                const int n = n0 + q; bf16* dst = (bf16*)(ws + (kd ? WS_VCMP : WS_KCMP)) + ((size_t)bg * 256 + n) * 64 + d; *dst = (bf16)f2bf((n < 255) ? a : 0.f); }
            __syncthreads();
        }
        (void)w2;
    }
    xcd_barrier(bar);

    {
        LAS float* qs = (LAS float*)(lds + wave * 8192); LAS float* pb = qs + 256; LAS float* pc = pb + 256;
        const bf16* KC2 = (const bf16*)(ws + WS_KCMP); const bf16* VC2 = (const bf16*)(ws + WS_VCMP);
        const bf16* KS = KV + (size_t)2 * 8 * T * 64; const bf16* VS = KV + (size_t)3 * 8 * T * 64; const bf16* KW = KV + (size_t)4 * 8 * T * 64; const bf16* VW = KV + (size_t)5 * 8 * T * 64;
        for (int unit = gw; unit < 8 * T; unit += NGW) {
            const int t = unit & (T - 1), bg = unit >> 12, b = bg >> 1, g = bg & 1; const size_t row = (size_t)b * T + t;
            { const unsigned long long q4 = *(const GAS unsigned long long*)(NQ + row * 512 + g * 256 + 4 * lane);
              f32x4 qv; qv.x = bf2f((unsigned)q4 & 0xffffu) * 0.125f; qv.y = bf2f(((unsigned)q4) >> 16) * 0.125f; qv.z = bf2f((unsigned)(q4 >> 32) & 0xffffu) * 0.125f; qv.w = bf2f((unsigned)(q4 >> 48)) * 0.125f;
              *(LAS f32x4*)(qs + 4 * lane) = qv; }
            LDS_WAIT(); asm volatile("" ::: "memory");
            float slope[4];
#pragma unroll
            for (int h = 0; h < 4; ++h) slope[h] = exp2f(-(float)(g * 4 + h + 1));
            float oc[4] = {0.f, 0.f, 0.f, 0.f}, os[4], ow[4];
            const int nvalid = t >= 31 ? ((t - 31) >> 4) + 1 : 0;
            float impv = 0.f;
            if (nvalid > 0) {
                nsa_branch_bf<0>(KC2 + (size_t)bg * 256 * 64, VC2 + (size_t)bg * 256 * 64, 0xFull, t, nvalid, slope, qs, pb, pc, lane, oc);
#pragma unroll
                for (int h = 0; h < 4; ++h) { const LAS float* p = pc + h * 256 + 4 * lane; impv += p[0] + p[1] + p[2] + 0.5f * p[3] + (lane > 0 ? 0.5f * p[-1] : 0.f); }
            }
            const int cur = t >> 6;
            if (lane == 0 || lane == cur || lane == cur - 1) impv = 1e4f;
            if (lane * 64 > t) impv = NEGF;
            int rank = 0;
            for (int i = 0; i < 64; ++i) { const float vi = __shfl(impv, i); rank += ((vi > impv) || (vi == impv && i < lane)) ? 1 : 0; }
            const unsigned long long selmask = __ballot(rank < 16);
            nsa_branch_bf<1>(KS + (size_t)bg * T * 64, VS + (size_t)bg * T * 64, selmask, t, 0, slope, qs, pb, pc, lane, os);
            const int j0 = (t - 511 > 0 ? t - 511 : 0) >> 6;
            const unsigned long long wmask = ((cur == 63) ? ~0ull : ((1ull << (cur + 1)) - 1ull)) & ~((1ull << j0) - 1ull);
            nsa_branch_bf<2>(KW + (size_t)bg * T * 64, VW + (size_t)bg * T * 64, wmask, t, 0, slope, qs, pb, pc, lane, ow);
            const float* gt_ = GATE + row * 32 + g * 12;
#pragma unroll
            for (int h = 0; h < 4; ++h) { const float yv = gt_[h * 3 + 0] * oc[h] + gt_[h * 3 + 1] * os[h] + gt_[h * 3 + 2] * ow[h];
                Y[row * D + 512 + g * 256 + h * 64 + lane] = (bf16)f2bf(yv); }
        }
    }
    xcd_barrier(bar);

    {
        pg8::Gemm g{Y, Wo_t, M, D, D}; pg8::StaticOrder S; S.init(M, D, G, bx);
        pg8::EpiF32 E{out, D};
        pg8::gemm_phase<pg8::EpiF32, pg8::StaticOrder, true, true>(lds, g, S, E);
    }
    xcd_barrier(bar);

    {
        for (int row = gw; row < M; row += NGW) { const int b = row >> 12; const float* ad = ADA + (size_t)b * 6144;
            const GAS f32x4* xr = (const GAS f32x4*)(x + (size_t)row * D) + lane; GAS f32x4* mr = (GAS f32x4*)(out + (size_t)row * D) + lane;
            f32x4 v[4]; float s = 0.f;
#pragma unroll
            for (int j = 0; j < 4; ++j) { const f32x4 g1 = *(const GAS f32x4*)(ad + 2048 + 4 * lane + 256 * j); v[j] = xr[64 * j] * ALPHA + g1 * mr[64 * j]; s += (v[j].x + v[j].y) + (v[j].z + v[j].w); }
            const float mean = wave_sum(s) * (1.f / D); float s2 = 0.f;
#pragma unroll
            for (int j = 0; j < 4; ++j) { v[j] = v[j] - mean; s2 += (v[j].x * v[j].x + v[j].y * v[j].y) + (v[j].z * v[j].z + v[j].w * v[j].w); }
            const float rstd = 1.f / sqrtf(wave_sum(s2) * (1.f / D) + LN_EPS);
            GAS unsigned long long* o8 = (GAS unsigned long long*)(XN + (size_t)row * D) + lane;
#pragma unroll
            for (int j = 0; j < 4; ++j) { const int c = 4 * lane + 256 * j; const f32x4 lg = *(const GAS f32x4*)(ln1_g + c), lb_ = *(const GAS f32x4*)(ln1_b + c);
                const f32x4 x1 = v[j] * rstd * lg + lb_; mr[64 * j] = x1;
                const f32x4 sh = *(const GAS f32x4*)(ad + 3072 + c), sc = *(const GAS f32x4*)(ad + 4096 + c); const f32x4 h = x1 * (sc + 1.0f) + sh;
                o8[64 * j] = (unsigned long long)pk2(h.x, h.y) | ((unsigned long long)pk2(h.z, h.w) << 32); } }
    }
    xcd_barrier(bar);

    {
        pg8::Gemm g{XN, Wup_t, M, NUP, D}; pg8::StaticOrder S; S.init(M, NUP, G, bx);
        pg8::EpiSwiGLU E{U, FF};
        pg8::gemm_phase<pg8::EpiSwiGLU, pg8::StaticOrder, true, true>(lds, g, S, E);
    }
    xcd_barrier(bar);

    {
        pg8::Gemm g{U, Wdn_t, M, D, FF}; pg8::StaticOrder S; S.init(M, D, G, bx);
        pg8::EpiF32 E{FFN, D};
        pg8::gemm_phase<pg8::EpiF32, pg8::StaticOrder, true, true>(lds, g, S, E);
    }
    xcd_barrier(bar);

    {
        for (int row = gw; row < M; row += NGW) { const int b = row >> 12; const float* ad = ADA + (size_t)b * 6144;
            GAS f32x4* xr = (GAS f32x4*)(out + (size_t)row * D) + lane; const GAS f32x4* fr_ = (const GAS f32x4*)(FFN + (size_t)row * D) + lane;
            f32x4 v[4]; float s = 0.f;
#pragma unroll
            for (int j = 0; j < 4; ++j) { const f32x4 g2 = *(const GAS f32x4*)(ad + 5120 + 4 * lane + 256 * j); v[j] = xr[64 * j] * ALPHA + g2 * fr_[64 * j]; s += (v[j].x + v[j].y) + (v[j].z + v[j].w); }
            const float mean = wave_sum(s) * (1.f / D); float s2 = 0.f;
#pragma unroll
            for (int j = 0; j < 4; ++j) { v[j] = v[j] - mean; s2 += (v[j].x * v[j].x + v[j].y * v[j].y) + (v[j].z * v[j].z + v[j].w * v[j].w); }
            const float rstd = 1.f / sqrtf(wave_sum(s2) * (1.f / D) + LN_EPS);
#pragma unroll
            for (int j = 0; j < 4; ++j) { const int c = 4 * lane + 256 * j; const f32x4 lg = *(const GAS f32x4*)(ln2_g + c), lb_ = *(const GAS f32x4*)(ln2_b + c);
                xr[64 * j] = v[j] * rstd * lg + lb_; } }
    }
}

extern "C" void kernel_launch(void* const* d_in, const int* in_sizes, int n_in, void* d_out, int out_size, void* d_ws, size_t ws_size, hipStream_t stream) {
    static int grid = 0;
    if (grid == 0) {
        if (n_in != 21 || in_sizes[0] != M * D || out_size != M * D || ws_size < WS_END) { fprintf(stderr, "kernel_launch: unexpected problem (n_in %d, in0 %d, out %d, ws %zu); nothing launched\n", n_in, n_in > 0 ? in_sizes[0] : -1, out_size, ws_size); grid = -1; return; }
        int dev = 0, cus = 0, per_cu = 0;
        if (hipGetDevice(&dev) != hipSuccess || hipDeviceGetAttribute(&cus, hipDeviceAttributeMultiprocessorCount, dev) != hipSuccess) { grid = -1; return; }
        if (hipFuncSetAttribute((const void*)fwd_kernel, hipFuncAttributeMaxDynamicSharedMemorySize, LDS_BYTES) != hipSuccess) { fprintf(stderr, "kernel_launch: hipFuncSetAttribute failed\n"); grid = -1; return; }
        if (hipOccupancyMaxActiveBlocksPerMultiprocessor(&per_cu, (const void*)fwd_kernel, NWAVES * 64, LDS_BYTES) != hipSuccess || per_cu < 1) { fprintf(stderr, "kernel_launch: occupancy query says %d blocks per CU\n", per_cu); }
        (void)hipGetLastError();
        grid = cus;
        if (grid != 256) fprintf(stderr, "kernel_launch: %d CUs (expected 256)\n", grid);
    }
    if (grid < 0) return;
    if (hipMemsetAsync((char*)d_ws + WS_CTL, 0, CTL_ZERO_BYTES, stream) != hipSuccess) { fprintf(stderr, "kernel_launch: memset failed\n"); return; }
    Args a{};
    for (int i = 0; i < 21; ++i) a.in[i] = (const float*)d_in[i];
    a.out = (float*)d_out; a.ws = (unsigned char*)d_ws;
    hipLaunchKernelGGL(fwd_kernel, dim3(grid), dim3(NWAVES * 64), LDS_BYTES, stream, a);
}
```

```cpp
#include <hip/hip_runtime.h>
#include <cstdio>
#include <cstdint>
namespace pg8 {
#define PG8_LAS __attribute__((address_space(3)))
typedef unsigned short bf16_t;
typedef short bf16x8 __attribute__((ext_vector_type(8)));
typedef float f32x4 __attribute__((ext_vector_type(4)));
typedef unsigned u32x4 __attribute__((ext_vector_type(4)));
constexpr int BM = 256, BK = 64, HALF = 128, HTB = HALF * BK * 2  , STAGE_BYTES = 8 * HTB, NXCD = 8, WGM = 8;

__host__ __device__ __forceinline__ int lds_byte(int r, int c) { const int st = (r >> 4) * 2 + (c >> 5), rr = r & 15, cc = c & 31, ob = rr * 64 + cc * 2; return st * 1024 + (ob ^ (((ob >> 9) & 1) << 5)); }
__host__ __device__ __forceinline__ void stage_rc(int b, int& R, int& C) { const int st = b / 1024, sb = b % 1024, swz = sb ^ (((sb >> 9) & 1) << 5); R = (st >> 1) * 16 + swz / 64; C = (st & 1) * 32 + (swz % 64) / 2; }
__host__ __device__ __forceinline__ int perm32(int rho) { const int n = rho >> 4, i = rho & 15; return 8 * (i >> 2) + 4 * n + (i & 3); }

struct Unit { int pm, pn; };
struct Gemm { const bf16_t* A; const bf16_t* Bt; int M, N, K; };

struct StaticOrder {
    int nM, nN, nwg, G, c;
    __host__ __device__ void init(int M, int N, int G_, int c_) { nM = M / BM; nN = N / BM; nwg = nM * nN; G = G_; c = c_; }
    __host__ __device__ bool next(int i, Unit& u) const {
        const long L = (long)i * G + c; if (L >= nwg) return false;
        int wgid = (int)L; { const int q = nwg / NXCD, r = nwg % NXCD, xcd = wgid % NXCD, off = wgid / NXCD; wgid = (xcd < r ? xcd * (q + 1) : r * (q + 1) + (xcd - r) * q) + off; }
        const int nig = WGM * nN, gid = wgid / nig, fm = gid * WGM, gsz = (nM - fm) < WGM ? (nM - fm) : WGM;
        u.pm = fm + ((wgid % nig) % gsz); u.pn = (wgid % nig) / gsz; return true;
    }
    __device__ __forceinline__ void a_ready(const Unit&) const {}
    __device__ __forceinline__ void done(const Unit&) const {}
};

__device__ __forceinline__ unsigned cvt_pk_bf16(float lo, float hi) { unsigned r; asm volatile("v_cvt_pk_bf16_f32 %0, %1, %2" : "=v"(r) : "v"(lo), "v"(hi)); return r; }
typedef unsigned u32x2 __attribute__((ext_vector_type(2)));
__device__ __forceinline__ float fast_sigmoid(float x) { return __builtin_amdgcn_rcpf(1.0f + __expf(-x)); }
__device__ __forceinline__ float silu_f(float x) { return x * fast_sigmoid(x); }

struct EpiF32 {
    static constexpr bool PERM = false, AFTER_DRAIN = false;
    float* O; int ldc;
    __device__ __forceinline__ void operator()(const f32x4 (&acc)[2][2][4][2], const Unit& u, int wr, int wc, int fr, int fq) const {
        const int row0 = u.pm * BM + wr * 64 + fr, col0 = u.pn * BM + wc * 32 + 4 * fq;
#pragma unroll
        for (int ai = 0; ai < 2; ++ai)
#pragma unroll
            for (int m = 0; m < 4; ++m) { float* rowp = O + (size_t)(row0 + ai * HALF + m * 16) * ldc + col0;
#pragma unroll
                for (int bj = 0; bj < 2; ++bj)
#pragma unroll
                    for (int n = 0; n < 2; ++n) *(f32x4*)(rowp + bj * HALF + n * 16) = acc[ai][bj][m][n]; }
    }
};
struct EpiSwiGLU {
    static constexpr bool PERM = true, AFTER_DRAIN = false;
    bf16_t* U; int ldc;
    __device__ __forceinline__ void operator()(const f32x4 (&acc)[2][2][4][2], const Unit& u, int wr, int wc, int fr, int fq) const {
        const int row0 = u.pm * BM + wr * 64 + fr, col0 = u.pn * HALF + wc * 32 + 8 * fq;
#pragma unroll
        for (int ai = 0; ai < 2; ++ai)
#pragma unroll
            for (int m = 0; m < 4; ++m) { bf16_t* rowp = U + (size_t)(row0 + ai * HALF + m * 16) * ldc + col0;
                const f32x4 a0 = acc[ai][0][m][0], a1 = acc[ai][0][m][1], b0 = acc[ai][1][m][0], b1 = acc[ai][1][m][1];
                u32x4 w;
                w.x = cvt_pk_bf16(silu_f(a0[0]) * b0[0], silu_f(a0[1]) * b0[1]); w.y = cvt_pk_bf16(silu_f(a0[2]) * b0[2], silu_f(a0[3]) * b0[3]);
                w.z = cvt_pk_bf16(silu_f(a1[0]) * b1[0], silu_f(a1[1]) * b1[1]); w.w = cvt_pk_bf16(silu_f(a1[2]) * b1[2], silu_f(a1[3]) * b1[3]);
                *(u32x4*)rowp = w; }
    }
};
struct EpiProj {
    static constexpr bool PERM = true, AFTER_DRAIN = false;
    bf16_t *QH, *VH, *SG, *NQ, *KV; float *GH, *GATE; const float* lbl;
    __device__ __forceinline__ void operator()(const f32x4 (&acc)[2][2][4][2], const Unit& u, int wr, int wc, int fr, int fq) const {
        const int pn = u.pn; const int row0 = u.pm * BM + wr * 64 + fr; const int ch = wc * 32 + 8 * fq;
        if (pn < 2 || (pn >= 4 && pn < 10)) {
            bf16_t* base = pn < 2 ? QH : (pn < 6 ? VH : (pn < 8 ? SG : NQ)); const int mode = pn < 2 ? 1 : ((pn >= 6 && pn < 8) ? 2 : 0); const int cb = (pn & 1) * BM + ch;
#pragma unroll
            for (int ai = 0; ai < 2; ++ai)
#pragma unroll
                for (int m = 0; m < 4; ++m) { bf16_t* rowp = base + (size_t)(row0 + ai * HALF + m * 16) * 512 + cb;
#pragma unroll
                    for (int bj = 0; bj < 2; ++bj) { f32x4 v0 = acc[ai][bj][m][0], v1 = acc[ai][bj][m][1];
                        if (mode == 1) { for (int e = 0; e < 4; ++e) { v0[e] = silu_f(v0[e]); v1[e] = silu_f(v1[e]); } }
                        else if (pn >= 8) { v0 = v0 * (0.125f * 1.4426950408889634f); v1 = v1 * (0.125f * 1.4426950408889634f); }
                        else if (mode == 2) { for (int e = 0; e < 4; ++e) { v0[e] = fast_sigmoid(v0[e]); v1[e] = fast_sigmoid(v1[e]); } }
                        u32x4 w; w.x = cvt_pk_bf16(v0[0], v0[1]); w.y = cvt_pk_bf16(v0[2], v0[3]); w.z = cvt_pk_bf16(v1[0], v1[1]); w.w = cvt_pk_bf16(v1[2], v1[3]);
                        *(u32x4*)(rowp + bj * HALF) = w; } }
        } else if (pn < 4) {
            const int cb = (pn & 1) * BM + ch;
            float lb[2][8];
#pragma unroll
            for (int bj = 0; bj < 2; ++bj)
#pragma unroll
                for (int e = 0; e < 8; ++e) { const int c = cb + bj * HALF + e; lb[bj][e] = fast_sigmoid(lbl[c] - lbl[512 + c]); }
#pragma unroll
            for (int ai = 0; ai < 2; ++ai)
#pragma unroll
                for (int m = 0; m < 4; ++m) { float* rowp = GH + (size_t)(row0 + ai * HALF + m * 16) * 512 + cb;
#pragma unroll
                    for (int bj = 0; bj < 2; ++bj) { f32x4 v0 = acc[ai][bj][m][0], v1 = acc[ai][bj][m][1];
#pragma unroll
                        for (int e = 0; e < 4; ++e) { v0[e] = __logf(lb[bj][e] + (1.0f - lb[bj][e]) * fast_sigmoid(v0[e])); v1[e] = __logf(lb[bj][4 + e] + (1.0f - lb[bj][4 + e]) * fast_sigmoid(v1[e])); }
                        *(f32x4*)(rowp + bj * HALF) = v0; *(f32x4*)(rowp + bj * HALF + 4) = v1; } }
        } else if (pn < 13) {
#pragma unroll
            for (int ai = 0; ai < 2; ++ai)
#pragma unroll
                for (int m = 0; m < 4; ++m) { const int row = row0 + ai * HALF + m * 16; const int b = row >> 12, t = row & 4095;
#pragma unroll
                    for (int bj = 0; bj < 2; ++bj) { const f32x4 v0 = acc[ai][bj][m][0], v1 = acc[ai][bj][m][1];
                        bf16_t* pb_ = KV + ((size_t)((pn - 10) * 2 + bj) * 8 + (size_t)(b * 2 + (ch >> 6))) * (4096 * 64);
                        u32x4 w; w.x = cvt_pk_bf16(v0[0], v0[1]); w.y = cvt_pk_bf16(v0[2], v0[3]); w.z = cvt_pk_bf16(v1[0], v1[1]); w.w = cvt_pk_bf16(v1[2], v1[3]);
                        if (bj == 1 && pn >= 11) {
                            bf16_t* p = pb_ + (size_t)(ch & 63) * 4096 + t;
                            p[0 * 4096] = (bf16_t)(w.x & 0xffffu); p[1 * 4096] = (bf16_t)(w.x >> 16); p[2 * 4096] = (bf16_t)(w.y & 0xffffu); p[3 * 4096] = (bf16_t)(w.y >> 16);
                            p[4 * 4096] = (bf16_t)(w.z & 0xffffu); p[5 * 4096] = (bf16_t)(w.z >> 16); p[6 * 4096] = (bf16_t)(w.w & 0xffffu); p[7 * 4096] = (bf16_t)(w.w >> 16);
                        } else *(u32x4*)(pb_ + (size_t)t * 64 + (ch & 63)) = w; } }
        } else {
            if (ch < 24) {
#pragma unroll
                for (int ai = 0; ai < 2; ++ai)
#pragma unroll
                    for (int m = 0; m < 4; ++m) { float* rowp = GATE + (size_t)(row0 + ai * HALF + m * 16) * 32 + ch; f32x4 v0 = acc[ai][0][m][0], v1 = acc[ai][0][m][1];
#pragma unroll
                        for (int e = 0; e < 4; ++e) { v0[e] = fast_sigmoid(v0[e]); v1[e] = fast_sigmoid(v1[e]); }
                        *(f32x4*)rowp = v0; *(f32x4*)(rowp + 4) = v1; }
            }
        }
    }
};
template <class Epi, class Sched, bool ALIGN_EPI = false, bool SP2 = false>
__device__ __forceinline__ void gemm_phase(PG8_LAS unsigned char* lds, const Gemm g, const Sched& S, const Epi& E) {
    int tid_ = threadIdx.x; asm volatile("" : "+v"(tid_));
    const int tid = tid_, wid = __builtin_amdgcn_readfirstlane(tid >> 6), lane = tid & 63, wr = wid >> 2, wc = wid & 3, fr = lane & 15, fq = lane >> 4;
    const int K = g.K, nt = K / BK;
    unsigned voffA[2], voffB[2];
#pragma unroll
    for (int i = 0; i < 2; ++i) { int R, C; stage_rc(tid * 16 + i * 8192, R, C); const int Rb = Epi::PERM ? ((R & ~31) + perm32(R & 31)) : R;
        voffA[i] = (unsigned)(R * K + C) * 2u; voffB[i] = (unsigned)(Rb * K + C) * 2u; }
    const size_t kstep = (size_t)(BK * 2);
    const size_t hstep = (size_t)HALF * K * 2;
    const size_t tstep = 2 * hstep;
    const unsigned ldsw = (unsigned)wid * 1024u;
    const int aoff = lds_byte(wr * 64 + fr, fq * 8), boff = lds_byte(wc * 32 + fr, fq * 8);
#define PG8_SA(b, h) (((b) * 2 + (h)) * HTB)
#define PG8_SB(b, h) ((4 + (b) * 2 + (h)) * HTB)
#define PG8_STAGE(bufoff, gbase, voff) do { _Pragma("unroll") for (int _i = 0; _i < 2; ++_i) \
        __builtin_amdgcn_global_load_lds((const unsigned*)((const char*)(gbase) + (voff)[_i]), (PG8_LAS unsigned*)(lds + (bufoff) + ldsw + _i * 8192), 16, 0, 0); } while (0)
#define PG8_LDA(dst, b, h) do { _Pragma("unroll") for (int m = 0; m < 4; ++m) _Pragma("unroll") for (int k = 0; k < 2; ++k) dst[m][k] = *(const PG8_LAS bf16x8*)(lds + PG8_SA(b, h) + aoff + m * 2048 + k * 1024); } while (0)
#define PG8_LDB(dst, b, h) do { _Pragma("unroll") for (int n = 0; n < 2; ++n) _Pragma("unroll") for (int k = 0; k < 2; ++k) dst[n][k] = *(const PG8_LAS bf16x8*)(lds + PG8_SB(b, h) + boff + n * 2048 + k * 1024); } while (0)
#define PG8_MMA(ai, bj, At, Bt) do { __builtin_amdgcn_s_setprio(1); _Pragma("unroll") for (int m = 0; m < 4; ++m) _Pragma("unroll") for (int n = 0; n < 2; ++n) _Pragma("unroll") for (int k = 0; k < 2; ++k) \
        acc[ai][bj][m][n] = __builtin_amdgcn_mfma_f32_16x16x32_bf16(Bt[n][k], At[m][k], acc[ai][bj][m][n], 0, 0, 0); __builtin_amdgcn_s_setprio(0); } while (0)
#define PG8_WAIT_V(n) asm volatile("s_waitcnt vmcnt(" #n ")" ::: "memory")
#define PG8_WAIT_L(n) asm volatile("s_waitcnt lgkmcnt(" #n ")" ::: "memory")
#define PG8_BAR __builtin_amdgcn_s_barrier()
#define PG8_SCHED __builtin_amdgcn_sched_barrier(0)
    Unit cur, nxt; int ui = 0;
    if (!S.next(0, cur)) return;
    f32x4 acc[2][2][4][2];
#pragma unroll
    for (int a = 0; a < 2; ++a)
#pragma unroll
        for (int b = 0; b < 2; ++b)
#pragma unroll
            for (int m = 0; m < 4; ++m)
#pragma unroll
                for (int n = 0; n < 2; ++n) acc[a][b][m][n] = (f32x4){0.f, 0.f, 0.f, 0.f};
    bf16x8 At[4][2], B0[2][2], B1[2][2];
    const char* cA = (const char*)g.A + (size_t)cur.pm * tstep; const char* cB = (const char*)g.Bt + (size_t)cur.pn * tstep;
    S.a_ready(cur);
    if constexpr (SP2) {
        PG8_STAGE(PG8_SB(0, 0), cB, voffB); PG8_STAGE(PG8_SB(0, 1), cB + hstep, voffB); PG8_STAGE(PG8_SA(0, 0), cA, voffA); PG8_STAGE(PG8_SA(0, 1), cA + hstep, voffA);
        if (wr == 1) PG8_BAR;
        PG8_WAIT_V(2); PG8_BAR;
        PG8_STAGE(PG8_SB(1, 0), cB + kstep, voffB); PG8_STAGE(PG8_SA(1, 0), cA + kstep, voffA); PG8_STAGE(PG8_SB(1, 1), cB + hstep + kstep, voffB);
        PG8_WAIT_V(6); PG8_BAR;
    } else {
        PG8_STAGE(PG8_SB(0, 0), cB, voffB); PG8_STAGE(PG8_SA(0, 0), cA, voffA); PG8_STAGE(PG8_SB(0, 1), cB + hstep, voffB); PG8_STAGE(PG8_SA(0, 1), cA + hstep, voffA);
        if (wr == 1) PG8_BAR;
        PG8_WAIT_V(4); PG8_BAR;
        PG8_STAGE(PG8_SB(1, 0), cB + kstep, voffB); PG8_STAGE(PG8_SA(1, 0), cA + kstep, voffA); PG8_STAGE(PG8_SB(1, 1), cB + hstep + kstep, voffB);
        PG8_WAIT_V(6); PG8_BAR;
    }
    for (;;) {
        const bool has_next = S.next(ui + 1, nxt);
        const char* nA = has_next ? (const char*)g.A + (size_t)nxt.pm * tstep : cA; const char* nB = has_next ? (const char*)g.Bt + (size_t)nxt.pn * tstep : cB;
        for (int t = 0; t < nt; t += 2) {
            const bool last = (t == nt - 2);
            const char* a1 = cA + (size_t)(t + 1) * kstep;
            const char* a2 = last ? nA : cA + (size_t)(t + 2) * kstep; const char* b2 = last ? nB : cB + (size_t)(t + 2) * kstep;
            const char* a3 = a2 + kstep; const char* b3 = b2 + kstep;
            if (last && has_next) S.a_ready(nxt);
            if constexpr (SP2) {
            PG8_LDB(B0, 0, 0); PG8_LDB(B1, 0, 1); PG8_SCHED; PG8_LDA(At, 0, 0); PG8_STAGE(PG8_SA(1, 1), a1 + hstep, voffA);
            PG8_WAIT_V(8); PG8_WAIT_L(0); PG8_BAR; PG8_MMA(0, 0, At, B0); PG8_MMA(0, 1, At, B1); PG8_BAR; PG8_SCHED;
            PG8_LDA(At, 0, 1); PG8_STAGE(PG8_SB(0, 0), b2, voffB); PG8_STAGE(PG8_SB(0, 1), b2 + hstep, voffB); PG8_STAGE(PG8_SA(0, 0), a2, voffA);
            PG8_WAIT_V(8); PG8_WAIT_L(0); PG8_BAR; PG8_MMA(1, 0, At, B0); PG8_MMA(1, 1, At, B1); PG8_BAR; PG8_SCHED;
            PG8_LDB(B0, 1, 0); PG8_LDB(B1, 1, 1); PG8_SCHED; PG8_LDA(At, 1, 0); PG8_STAGE(PG8_SA(0, 1), a2 + hstep, voffA);
            PG8_WAIT_V(8); PG8_WAIT_L(0); PG8_BAR; PG8_MMA(0, 0, At, B0); PG8_MMA(0, 1, At, B1); PG8_BAR; PG8_SCHED;
            PG8_LDA(At, 1, 1); PG8_STAGE(PG8_SB(1, 0), b3, voffB); PG8_STAGE(PG8_SB(1, 1), b3 + hstep, voffB); PG8_STAGE(PG8_SA(1, 0), a3, voffA);
            PG8_WAIT_V(8); PG8_WAIT_L(0); PG8_BAR; PG8_MMA(1, 0, At, B0); PG8_MMA(1, 1, At, B1); PG8_BAR; PG8_SCHED;
            } else {
            PG8_LDB(B0, 0, 0); PG8_SCHED; PG8_LDA(At, 0, 0); PG8_STAGE(PG8_SA(1, 1), a1 + hstep, voffA);
            PG8_WAIT_L(8); PG8_BAR; PG8_WAIT_L(0); PG8_MMA(0, 0, At, B0); PG8_BAR; PG8_SCHED;
            PG8_LDB(B1, 0, 1); PG8_STAGE(PG8_SB(0, 0), b2, voffB);
            PG8_BAR; PG8_WAIT_L(0); PG8_MMA(0, 1, At, B1); PG8_BAR;
            PG8_LDA(At, 0, 1); PG8_STAGE(PG8_SA(0, 0), a2, voffA);
            PG8_BAR; PG8_WAIT_L(0); PG8_MMA(1, 0, At, B0); PG8_BAR; PG8_SCHED;
            PG8_STAGE(PG8_SB(0, 1), b2 + hstep, voffB);
            PG8_WAIT_V(6); PG8_BAR; PG8_MMA(1, 1, At, B1); PG8_BAR;
            PG8_LDB(B0, 1, 0); PG8_SCHED; PG8_LDA(At, 1, 0); PG8_STAGE(PG8_SA(0, 1), a2 + hstep, voffA);
            PG8_WAIT_L(8); PG8_BAR; PG8_WAIT_L(0); PG8_MMA(0, 0, At, B0); PG8_BAR; PG8_SCHED;
            PG8_LDB(B1, 1, 1); PG8_STAGE(PG8_SB(1, 0), b3, voffB);
            PG8_BAR; PG8_WAIT_L(0); PG8_MMA(0, 1, At, B1); PG8_BAR;
            PG8_LDA(At, 1, 1); PG8_STAGE(PG8_SA(1, 0), a3, voffA);
            PG8_BAR; PG8_WAIT_L(0); PG8_MMA(1, 0, At, B0); PG8_BAR; PG8_SCHED;
            PG8_STAGE(PG8_SB(1, 1), b3 + hstep, voffB);
            PG8_WAIT_V(6); PG8_BAR; PG8_MMA(1, 1, At, B1); PG8_BAR;
            }
        }
        if constexpr (ALIGN_EPI) { if (wr == 0) PG8_BAR; }
        if constexpr (!Epi::AFTER_DRAIN) { E(acc, cur, wr, wc, fr, fq); S.done(cur); }
        if (!has_next) break;
#pragma unroll
        for (int a = 0; a < 2; ++a)
#pragma unroll
            for (int b = 0; b < 2; ++b)
#pragma unroll
                for (int m = 0; m < 4; ++m)
#pragma unroll
                    for (int n = 0; n < 2; ++n) acc[a][b][m][n] = (f32x4){0.f, 0.f, 0.f, 0.f};
        cur = nxt; cA = nA; cB = nB; ++ui;
        if constexpr (ALIGN_EPI) { if (wr == 1) PG8_BAR; }
    }
    PG8_WAIT_V(0);
    if constexpr (!ALIGN_EPI) { if (wr == 0) PG8_BAR; }
    PG8_BAR;
    if constexpr (Epi::AFTER_DRAIN) { E.fused(acc, cur, wr, wc, fr, fq, lds, wid, lane); S.done(cur); }
#undef PG8_SA
#undef PG8_SB
#undef PG8_STAGE
#undef PG8_LDA
#undef PG8_LDB
#undef PG8_MMA
#undef PG8_WAIT_V
#undef PG8_WAIT_L
#undef PG8_BAR
#undef PG8_SCHED
}
}

constexpr int NWAVES = 8;
constexpr int NB = 4, T = 4096, D = 1024, M = NB * T, NIN = 3352, NINP = 3584, FF = 2816, NUP = 2 * FF;
constexpr float LN_EPS = 1e-5f, RMS_EPS = 1e-6f, ALPHA = 1.189207115002721f;
constexpr float NEGF = -1e30f;
constexpr size_t MiB = 1u << 20;
constexpr size_t WS_CTL = 0, CTL_ZERO_BYTES = 1 * MiB;
constexpr size_t WS_ADAP = 1 * MiB;
constexpr size_t WS_ADA = 2 * MiB + 512 * 1024;
constexpr size_t WS_W2T = 2 * MiB + 640 * 1024;
constexpr size_t WS_PB = 2 * MiB + 704 * 1024;
constexpr size_t WS_W1T = 30 * MiB;
constexpr size_t WS_KCMP = 2 * MiB + 768 * 1024;
constexpr size_t WS_VCMP = 3 * MiB + 256 * 1024;
constexpr size_t WS_WIN = 4 * MiB, WS_WO = 11 * MiB, WS_WUP = 13 * MiB, WS_WDN = 24 * MiB;
constexpr size_t WS_XN = 32 * MiB;
constexpr size_t WS_Y = 64 * MiB;
constexpr size_t WS_QH = 96 * MiB, WS_GH = 112 * MiB, WS_VH = 144 * MiB, WS_SG = 160 * MiB, WS_NQ = 176 * MiB, WS_KV = 192 * MiB, WS_GATE = 216 * MiB;
constexpr size_t WS_U = 96 * MiB;
constexpr size_t WS_FFN = 184 * MiB;
constexpr size_t WS_DS = 218 * MiB;
constexpr size_t WS_DEC = 250 * MiB;
constexpr size_t WS_END = 256 * MiB;
constexpr int CW_BAR = 4096;
constexpr int RING_BYTES = 131072, LDSCTL_OFF = RING_BYTES, MISC_OFF = LDSCTL_OFF + 320, LDS_BYTES = 147456;

#define GAS __attribute__((address_space(1)))
#define LAS __attribute__((address_space(3)))
typedef unsigned short bf16;
typedef unsigned v4u __attribute__((ext_vector_type(4)));
typedef float f32x4 __attribute__((ext_vector_type(4)));
#define LDS_WAIT() asm volatile("s_waitcnt lgkmcnt(0)" ::: "memory")
#define VM_WAIT() asm volatile("s_waitcnt vmcnt(0)" ::: "memory")
__device__ __forceinline__ unsigned f2bf(float f) { unsigned u = __builtin_bit_cast(unsigned, f); return (u + 0x7fffu + ((u >> 16) & 1u)) >> 16; }
__device__ __forceinline__ unsigned pk2(float lo, float hi) { return f2bf(lo) | (f2bf(hi) << 16); }
__device__ __forceinline__ float bf2f(unsigned u) { return __builtin_bit_cast(float, u << 16); }
__device__ __forceinline__ float wave_sum(float v) {
#pragma unroll
    for (int o = 1; o < 64; o <<= 1) v += __shfl_xor(v, o);
    return v;
}
__device__ __forceinline__ float wave_max(float v) {
#pragma unroll
    for (int o = 1; o < 64; o <<= 1) v = fmaxf(v, __shfl_xor(v, o));
    return v;
}
#define XB_TMO      128
#define XB_XCNT(j)  (256  + 64 * (j))
#define XB_XSUB(j)  (1280 + 64 * (j))
#define XB_XGEN(j)  (2304 + 64 * (j))
#define XB_TOP      3328
#define XB_TOPGEN   3392
#define XCD_BAR_WORDS 3456
#define XB_SPIN_CAP (1u << 18)

__device__ __forceinline__ unsigned xb_ld(unsigned* p)              { return __hip_atomic_load(p, __ATOMIC_RELAXED, __HIP_MEMORY_SCOPE_AGENT); }
__device__ __forceinline__ unsigned xb_add(unsigned* p, unsigned v) { return __hip_atomic_fetch_add(p, v, __ATOMIC_RELAXED, __HIP_MEMORY_SCOPE_AGENT); }
__device__ __forceinline__ unsigned xb_xcc_id() { return (unsigned)__builtin_amdgcn_s_getreg((3 << 11) | 20) & 0xFu; }
#define XB_SPIN(cond, bar) do { unsigned _sp = 0; while (cond) { __builtin_amdgcn_s_sleep(1); \
    if ((++_sp & 255u) == 0u) { if (xb_ld(&(bar)[XB_TMO])) break; if (_sp > XB_SPIN_CAP) { atomicAdd(&(bar)[XB_TMO], 1u); break; } } } } while (0)

struct XcdBarrier {
    unsigned* bar; unsigned x;
    volatile LAS unsigned* st;
};

__device__ __forceinline__ XcdBarrier xcd_barrier_post(unsigned* bar, volatile LAS unsigned* st) {
    XcdBarrier b; b.bar = bar; b.x = xb_xcc_id(); b.st = st;
    if (threadIdx.x == 0) (void)xb_add(&bar[XB_XCNT(b.x)], 1u);
    return b;
}
__device__ __forceinline__ void xcd_barrier_complete(unsigned* bar, unsigned x, unsigned& nloc, unsigned& nx) {
    const unsigned G = gridDim.x * gridDim.y * gridDim.z;
    unsigned sum, cnt, mine, sp = 0u;
    for (;;) {
        sum = 0u; cnt = 0u; mine = 0u;
#pragma unroll
        for (unsigned j = 0; j < 16; ++j) { const unsigned c = xb_ld(&bar[XB_XCNT(j)]); sum += c; cnt += (c > 0u) ? 1u : 0u; mine = (j == x) ? c : mine; }
        if (sum == G) break;
        __builtin_amdgcn_s_sleep(1);
        if ((++sp & 255u) == 0u) { if (xb_ld(&bar[XB_TMO])) break; if (sp > XB_SPIN_CAP) { atomicAdd(&bar[XB_TMO], 1u); break; } }
    }
    nloc = mine > 0u ? mine : 1u; nx = cnt > 0u ? cnt : 1u;
}

__device__ __forceinline__ void xcd_barrier(const XcdBarrier& b) {
    asm volatile("s_waitcnt vmcnt(0)" ::: "memory");
    __syncthreads();
    if (threadIdx.x == 0) {
        unsigned* bar = b.bar;
        __builtin_amdgcn_s_waitcnt(0);
        unsigned nloc = b.st[0], nx = b.st[1];
        if (nloc == 0u) { xcd_barrier_complete(bar, b.x, nloc, nx); b.st[0] = nloc; b.st[1] = nx; }
        const unsigned old = xb_add(&bar[XB_XSUB(b.x)], 1u);
        const unsigned gen = old / nloc;
        if (old + 1u == (gen + 1u) * nloc) {
            __builtin_amdgcn_fence(__ATOMIC_RELEASE, "agent");
            asm volatile("s_waitcnt vmcnt(0)" ::: "memory");
            const unsigned og = xb_add(&bar[XB_TOP], 1u);
            const unsigned tg = og / nx;
            if (og + 1u == (tg + 1u) * nx) xb_add(&bar[XB_TOPGEN], 1u);
            else XB_SPIN(xb_ld(&bar[XB_TOPGEN]) == tg, bar);
            __builtin_amdgcn_fence(__ATOMIC_ACQUIRE, "agent");
            xb_add(&bar[XB_XGEN(b.x)], 1u);
            asm volatile("s_waitcnt vmcnt(0)" ::: "memory");
        } else {
            XB_SPIN(xb_ld(&bar[XB_XGEN(b.x)]) == gen, bar);
            __builtin_amdgcn_fence(__ATOMIC_ACQUIRE, "agent");
            asm volatile("s_waitcnt vmcnt(0)" ::: "memory");
        }
    }
    __syncthreads();
}

__device__ __forceinline__ void transpose_item(const float* W, int K, int N, bf16* WT, int dst_row0, LAS float* scr, int k0, int n0, int lane) {
#pragma unroll 8
    for (int i = 0; i < 32; ++i) { const int kk = 2 * i + (lane >> 5); const int n = n0 + (lane & 31); scr[kk * 33 + (lane & 31)] = (n < N) ? W[(size_t)(k0 + kk) * N + n] : 0.f; }
    LDS_WAIT(); asm volatile("" ::: "memory");
    const int c = lane & 7;
#pragma unroll
    for (int j = 0; j < 4; ++j) { const int n = (lane >> 3) + 8 * j; const LAS float* s = scr + (8 * c) * 33 + n;
        v4u o; o.x = pk2(s[0 * 33], s[1 * 33]); o.y = pk2(s[2 * 33], s[3 * 33]); o.z = pk2(s[4 * 33], s[5 * 33]); o.w = pk2(s[6 * 33], s[7 * 33]);
        *(GAS v4u*)(WT + (size_t)(dst_row0 + n) * K + k0 + 8 * c) = o; }
    LDS_WAIT(); asm volatile("" ::: "memory");
}

struct Args { const float* in[21]; float* out; unsigned char* ws; };

typedef short bf16x8v __attribute__((ext_vector_type(8)));
typedef float f32x16 __attribute__((ext_vector_type(16)));
constexpr float LOG2E = 1.4426950408889634f;
constexpr int NSA_KSTR = 144, NSA_VSTR = 136;
constexpr int NSA_KB = 0, NSA_VB = 2 * 64 * NSA_KSTR, NSA_IMP = NSA_VB + 2 * 64 * NSA_VSTR, NSA_SEL = NSA_IMP + 4 * 64 * 64 * 4, NSA_END = NSA_SEL + 512;
static_assert(NSA_END <= RING_BYTES && (NSA_VB % 16) == 0 && (NSA_IMP % 16) == 0, "NSA LDS map");

template <int BR>
__device__ __forceinline__ void nsa_tile(const LAS unsigned char* kb, const LAS unsigned char* vb, const bf16x8v (&qf)[4], f32x16 (&O)[2], float& m, float& l,
                                         float slope2, float e0, float elo, float ehi, bool domask, int rA, int h2, LAS float* improw, int jbase) {
    constexpr float posmul = (BR <= 1) ? 16.f : 1.f;
    f32x16 s0, s1;
#pragma unroll
    for (int r = 0; r < 16; ++r) { s0[r] = 0.f; s1[r] = 0.f; }
#pragma unroll
    for (int ks = 0; ks < 4; ++ks) {
        const bf16x8v a0 = *(const LAS bf16x8v*)(kb + rA * NSA_KSTR + ks * 32 + h2 * 16), a1 = *(const LAS bf16x8v*)(kb + (32 + rA) * NSA_KSTR + ks * 32 + h2 * 16);
        s0 = __builtin_amdgcn_mfma_f32_32x32x16_bf16(a0, qf[ks], s0, 0, 0, 0); s1 = __builtin_amdgcn_mfma_f32_32x32x16_bf16(a1, qf[ks], s1, 0, 0, 0);
    }
    const float NINF = -__builtin_inff();
    float tmax = NINF;
#pragma unroll
    for (int r = 0; r < 16; ++r) { const float kc = (float)((r & 3) + 8 * (r >> 2));
        const float ea = e0 + posmul * kc, eb = e0 + posmul * (kc + 32.f);
        float va = __builtin_fmaf(slope2, ea, s0[r]), vb_ = __builtin_fmaf(slope2, eb, s1[r]);
        if (domask) { va = (ea > elo && ea <= ehi) ? va : NINF; vb_ = (eb > elo && eb <= ehi) ? vb_ : NINF; }
        s0[r] = va; s1[r] = vb_; tmax = fmaxf(tmax, fmaxf(va, vb_)); }
    float alpha = 1.f;
    if (BR != 1) { tmax = fmaxf(tmax, __shfl_xor(tmax, 32)); const float mn = fmaxf(m, tmax); alpha = __builtin_amdgcn_exp2f(m - mn); m = mn; }
    float rs = 0.f;
#pragma unroll
    for (int r = 0; r < 16; ++r) { s0[r] = __builtin_amdgcn_exp2f(s0[r] - m); s1[r] = __builtin_amdgcn_exp2f(s1[r] - m); rs += s0[r] + s1[r]; }
    if (BR == 0) { l = l * alpha + rs; return; }
    if (BR == 1) {
#pragma unroll
        for (int r = 0; r < 16; ++r) { s0[r] *= l; s1[r] *= l; }
#pragma unroll
        for (int kg = 0; kg < 2; ++kg)
#pragma unroll
            for (int g4 = 0; g4 < 4; ++g4) { const f32x16& sp = kg ? s1 : s0; const float mainv = sp[4 * g4] + sp[4 * g4 + 1] + sp[4 * g4 + 2] + 0.5f * sp[4 * g4 + 3];
                __hip_atomic_fetch_add(improw + jbase + 8 * kg + 2 * g4 + h2, mainv, __ATOMIC_RELAXED, __HIP_MEMORY_SCOPE_WORKGROUP); }
#pragma unroll
        for (int kg = 0; kg < 2; ++kg)
#pragma unroll
            for (int g4 = 0; g4 < 4; ++g4) { const f32x16& sp = kg ? s1 : s0; const int jp = jbase + 8 * kg + 2 * g4 + h2 + 1;
                if (jp < 64) __hip_atomic_fetch_add(improw + jp, 0.5f * sp[4 * g4 + 3], __ATOMIC_RELAXED, __HIP_MEMORY_SCOPE_WORKGROUP); }
    } else {
        l = l * alpha + rs;
#pragma unroll
        for (int r = 0; r < 16; ++r) { O[0][r] *= alpha; O[1][r] *= alpha; }
    }
    bf16x8v pf[2][2];
#pragma unroll
    for (int kg = 0; kg < 2; ++kg)
#pragma unroll
        for (int s = 0; s < 2; ++s) { const f32x16& sp = kg ? s1 : s0; typedef unsigned u4 __attribute__((ext_vector_type(4))); u4 w;
            w.x = pg8::cvt_pk_bf16(sp[8 * s + 0], sp[8 * s + 1]); w.y = pg8::cvt_pk_bf16(sp[8 * s + 2], sp[8 * s + 3]); w.z = pg8::cvt_pk_bf16(sp[8 * s + 4], sp[8 * s + 5]); w.w = pg8::cvt_pk_bf16(sp[8 * s + 6], sp[8 * s + 7]);
            pf[kg][s] = __builtin_bit_cast(bf16x8v, w); }
#pragma unroll
    for (int dt = 0; dt < 2; ++dt)
#pragma unroll
        for (int kg = 0; kg < 2; ++kg)
#pragma unroll
            for (int s = 0; s < 2; ++s) { const LAS unsigned char* vp = vb + (dt * 32 + rA) * NSA_VSTR + kg * 64 + s * 32 + h2 * 8;
                typedef unsigned long long u64x2 __attribute__((ext_vector_type(2))); u64x2 av; av.x = *(const LAS unsigned long long*)vp; av.y = *(const LAS unsigned long long*)(vp + 16);
                O[dt] = __builtin_amdgcn_mfma_f32_32x32x16_bf16(__builtin_bit_cast(bf16x8v, av), pf[kg][s], O[dt], 0, 0, 0); }
}

template <int BR>
__device__ __forceinline__ void nsa_loop(unsigned long long tiles, const bf16* Kg, const bf16* Vtg, int vstride, LAS unsigned char* lds, int tid, const bf16x8v (&qf)[4], f32x16 (&O)[2], float& m, float& l,
                                         float slope2, int tq, int cur, unsigned long long mymask, int rA, int h2, LAS float* improw) {
    if (tiles == 0ull) return;
    const int srow = tid >> 3, sch = tid & 7;
    v4u kr, vr;
    { const int j = __builtin_ctzll(tiles); kr = *(const GAS v4u*)(Kg + (size_t)(64 * j + srow) * 64 + sch * 8); vr = *(const GAS v4u*)(Vtg + (size_t)srow * vstride + 64 * j + sch * 8); }
    int buf = 0;
    { *(LAS v4u*)(lds + NSA_KB + srow * NSA_KSTR + sch * 16) = kr; LAS unsigned long long* vp = (LAS unsigned long long*)(lds + NSA_VB + srow * NSA_VSTR + sch * 16);
      vp[0] = (unsigned long long)vr.x | ((unsigned long long)vr.y << 32); vp[1] = (unsigned long long)vr.z | ((unsigned long long)vr.w << 32); }
    __syncthreads();
    while (tiles) {
        const int j = __builtin_ctzll(tiles); tiles &= tiles - 1;
        const bool more = tiles != 0ull;
        if (more) { const int jn = __builtin_ctzll(tiles); kr = *(const GAS v4u*)(Kg + (size_t)(64 * jn + srow) * 64 + sch * 8); vr = *(const GAS v4u*)(Vtg + (size_t)srow * vstride + 64 * jn + sch * 8); }
        const float posmul = (BR <= 1) ? 16.f : 1.f, posadd = (BR <= 1) ? 31.f : 0.f;
        const float e0 = posmul * (float)(64 * j + 4 * h2) + posadd - (float)tq;
        float elo = -__builtin_inff(), ehi = 0.f; bool domask = true;
        if (BR == 2) { ehi = ((mymask >> j) & 1ull) ? 0.f : -__builtin_inff(); }
        if (BR == 3) { elo = -512.f; domask = (j == cur) || (j == cur - 8); }
        nsa_tile<BR>(lds + NSA_KB + buf * 64 * NSA_KSTR, lds + NSA_VB + buf * 64 * NSA_VSTR, qf, O, m, l, slope2, e0, elo, ehi, domask, rA, h2, improw, 16 * j);
        if (more) { const int nb = buf ^ 1; *(LAS v4u*)(lds + NSA_KB + nb * 64 * NSA_KSTR + srow * NSA_KSTR + sch * 16) = kr;
            LAS unsigned long long* vp = (LAS unsigned long long*)(lds + NSA_VB + nb * 64 * NSA_VSTR + srow * NSA_VSTR + sch * 16);
            vp[0] = (unsigned long long)vr.x | ((unsigned long long)vr.y << 32); vp[1] = (unsigned long long)vr.z | ((unsigned long long)vr.w << 32); }
        __syncthreads();
        buf ^= 1;
    }
}

#define xin ((const float*)args.in[0])
#define cvec ((const float*)args.in[1])
#define w_ada ((const float*)args.in[2])
#define b_ada ((const float*)args.in[3])
#define w_in ((const float*)args.in[4])
#define lbl ((const float*)args.in[5])
#define hg_norm_g ((const float*)args.in[6])
#define pos_k ((const float*)args.in[7])
#define w1_k ((const float*)args.in[8])
#define w2_k ((const float*)args.in[9])
#define pos_v ((const float*)args.in[10])
#define w1_v ((const float*)args.in[11])
#define w2_v ((const float*)args.in[12])
#define w_out ((const float*)args.in[13])
#define ln1_g ((const float*)args.in[14])
#define ln1_b ((const float*)args.in[15])
#define ffn_w1 ((const float*)args.in[16])
#define ffn_w3 ((const float*)args.in[17])
#define ffn_w2 ((const float*)args.in[18])
#define ln2_g ((const float*)args.in[19])
#define ln2_b ((const float*)args.in[20])
#define out (args.out)
#define ADAP ((float*)(ws + WS_ADAP))
#define ADA ((float*)(ws + WS_ADA))
#define Win_t ((bf16*)(ws + WS_WIN))
#define Wo_t ((bf16*)(ws + WS_WO))
#define Wup_t ((bf16*)(ws + WS_WUP))
#define Wdn_t ((bf16*)(ws + WS_WDN))
#define XN ((bf16*)(ws + WS_XN))
#define Y ((bf16*)(ws + WS_Y))
#define QH ((bf16*)(ws + WS_QH))
#define GH ((float*)(ws + WS_GH))
#define VH ((bf16*)(ws + WS_VH))
#define SG ((bf16*)(ws + WS_SG))
#define NQ ((bf16*)(ws + WS_NQ))
#define KV ((bf16*)(ws + WS_KV))
#define GATE ((float*)(ws + WS_GATE))
#define U ((bf16*)(ws + WS_U))
#define FFN ((float*)(ws + WS_FFN))
__global__ void __launch_bounds__(NWAVES * 64, 2) fwd_kernel(Args args) {
    extern __shared__ __attribute__((aligned(16))) unsigned char lds_raw[];
    LAS unsigned char* lds = (LAS unsigned char*)lds_raw;
    volatile LAS unsigned* MISC = (volatile LAS unsigned*)(lds + MISC_OFF);
    const int tid = threadIdx.x, lane = tid & 63, wave = __builtin_amdgcn_readfirstlane(tid >> 6);
    const int G = gridDim.x; const int bx = blockIdx.x; const int vcu = (G % 8 == 0) ? (bx % 8) * (G / 8) + bx / 8 : bx;
    unsigned char* ws = args.ws;
    unsigned* ctl = (unsigned*)(ws + WS_CTL);
    for (int u = tid; u < (LDS_BYTES - LDSCTL_OFF) / 4; u += NWAVES * 64) ((LAS unsigned*)(lds + LDSCTL_OFF))[u] = 0u;
    __syncthreads();
    XcdBarrier bar = xcd_barrier_post(ctl + CW_BAR, MISC + 8);
    const int gw = vcu * NWAVES + wave, NGW = G * NWAVES;

    {
        LAS float* scr = (LAS float*)(lds + wave * 16384);
        constexpr int I_IN = 105 * 16, I_O = 32 * 16, I_1 = 88 * 16, I_2 = 32 * 44;
        constexpr int NITEMS = I_IN + I_O + 2 * I_1 + I_2 + 512 + 16;
        for (int it = gw; it < NITEMS; it += NGW) {
            int r = it;
            if (r < I_IN) { const int kb = r / 105, nb = r % 105; transpose_item(w_in, D, NIN, Win_t, 32 * nb, scr, 64 * kb, 32 * nb, lane); continue; } r -= I_IN;
            if (r < I_O) { const int kb = r / 32, nb = r % 32; transpose_item(w_out, D, D, Wo_t, 32 * nb, scr, 64 * kb, 32 * nb, lane); continue; } r -= I_O;
            if (r < I_1) { const int kb = r / 88, nb = r % 88; const int n0 = 32 * nb; transpose_item(ffn_w1, D, FF, Wup_t, 256 * (n0 >> 7) + (n0 & 127), scr, 64 * kb, n0, lane); continue; } r -= I_1;
            if (r < I_1) { const int kb = r / 88, nb = r % 88; const int n0 = 32 * nb; transpose_item(ffn_w3, D, FF, Wup_t, 256 * (n0 >> 7) + 128 + (n0 & 127), scr, 64 * kb, n0, lane); continue; } r -= I_1;
            if (r < I_2) { const int kb = r / 32, nb = r % 32; transpose_item(ffn_w2, FF, D, Wdn_t, 32 * nb, scr, 64 * kb, 32 * nb, lane); continue; } r -= I_2;
            if (r < 512) { const int kd = r >> 8, kb = (r & 255) >> 3, nb = r & 7; transpose_item(kd ? w1_v : w1_k, 2048, 256, (bf16*)(ws + WS_W1T) + (size_t)kd * 256 * 2048, 32 * nb, scr, 64 * kb, 32 * nb, lane); continue; } r -= 512;
            { const int kd = r >> 3, kb = (r & 7) >> 1, nb = r & 1; transpose_item(kd ? w2_v : w2_k, 256, 64, (bf16*)(ws + WS_W2T) + (size_t)kd * 64 * 256, 32 * nb, scr, 64 * kb, 32 * nb, lane); }
        }
        { const int gt = vcu * 512 + tid;
          if (gt < 2 * 32 * 256) { const int kd = gt >> 13, s = (gt >> 8) & 31, j = gt & 255; const float* w1p = kd ? w1_v : w1_k; const float* pp = kd ? pos_v : pos_k; float a = 0.f;
            for (int i = 64 * s; i < 64 * s + 64; ++i) a += pp[i] * w1p[(size_t)i * 256 + j];
            ((float*)(ws + WS_PB))[gt] = a; } }
        { const int gt = vcu * 512 + tid; constexpr int NZ = (NINP - 3360) * D * 2 / 16; v4u z; z.x = z.y = z.z = z.w = 0u;
          for (int i = gt; i < NZ; i += G * 512) ((GAS v4u*)(Win_t + (size_t)3360 * D))[i] = z; }
        { const int gt = vcu * 512 + tid;
          if (gt < 16 * 6144) { const int ks = gt / 6144, col = gt % 6144; float a0 = 0.f, a1 = 0.f, a2 = 0.f, a3 = 0.f;
            for (int k = ks * 64; k < ks * 64 + 64; ++k) { const float w = w_ada[(size_t)k * 6144 + col];
                const float c0 = cvec[k], c1 = cvec[D + k], c2 = cvec[2 * D + k], c3 = cvec[3 * D + k];
                a0 += pg8::silu_f(c0) * w; a1 += pg8::silu_f(c1) * w; a2 += pg8::silu_f(c2) * w; a3 += pg8::silu_f(c3) * w; }
            float* p = ADAP + (size_t)ks * 4 * 6144 + col; p[0] = a0; p[6144] = a1; p[2 * 6144] = a2; p[3 * 6144] = a3; } }
    }
    xcd_barrier(bar);

    {
        { const int gt = vcu * 512 + tid;
          if (gt < 4 * 6144) { const int col = gt % 6144; float a = b_ada[col];
            for (int ks = 0; ks < 16; ++ks) a += ADAP[(size_t)ks * 4 * 6144 + gt];
            ADA[gt] = a; } }
        LAS float* shs = (LAS float*)lds;
        const int b = (vcu * 64) >> 12;
        for (int i = tid; i < 2048; i += 512) { float a = b_ada[i];
            for (int ks = 0; ks < 16; ++ks) a += ADAP[(size_t)ks * 4 * 6144 + b * 6144 + i];
            shs[i] = a; }
        __syncthreads();
        for (int r = 0; r < 8; ++r) { const int row = vcu * 64 + wave * 8 + r;
            const GAS f32x4* xr = (const GAS f32x4*)(xin + (size_t)row * D) + lane;
            GAS unsigned long long* o8 = (GAS unsigned long long*)(XN + (size_t)row * D) + lane;
#pragma unroll
            for (int j = 0; j < 4; ++j) { const f32x4 v = xr[64 * j]; const f32x4 sh = *(const LAS f32x4*)(shs + 4 * lane + 256 * j), sc = *(const LAS f32x4*)(shs + 1024 + 4 * lane + 256 * j);
                const f32x4 h = v * (sc + 1.0f) + sh;
                o8[64 * j] = (unsigned long long)pk2(h.x, h.y) | ((unsigned long long)pk2(h.z, h.w) << 32); } }
        __syncthreads();
    }
    xcd_barrier(bar);

    {
        pg8::Gemm g{XN, Win_t, M, NINP, D}; pg8::StaticOrder S; S.init(M, NINP, G, bx);
        pg8::EpiProj E{QH, VH, SG, NQ, KV, GH, GATE, lbl};
        pg8::gemm_phase<pg8::EpiProj, pg8::StaticOrder, true, true>(lds, g, S, E);
    }
    xcd_barrier(bar);

    {
        constexpr int HQ = 0, HK = 64 * 272, HA = HK + 160 * 272, HV = HA + 64 * 144, HKH = HV + 128 * 144, HT = HKH + 128 * 144;
        static_assert(HT + 4096 <= RING_BYTES, "HGRN2 LDS map");
        typedef short bf16x8v_ __attribute__((ext_vector_type(8)));
        float* DEC = (float*)(ws + WS_DEC); bf16* DS = (bf16*)(ws + WS_DS);
        const int d = tid & 127, seg = __builtin_amdgcn_readfirstlane(tid >> 7), fr = lane & 15, fq = lane >> 4;
        for (int rep = 0; rep < 4; ++rep) {
            const int unit = vcu * 4 + rep; const int bh = unit >> 6, c = unit & 63, b = bh >> 2, h = bh & 3;
            const size_t row0 = (size_t)b * T + 64 * c; const int col0 = h * 128;
            float g[16], qv[16]; unsigned vraw[16];
#pragma unroll
            for (int i = 0; i < 16; ++i) { const size_t gi = (row0 + 16 * seg + i) * 512 + col0 + d; g[i] = GH[gi]; qv[i] = bf2f(QH[gi]); vraw[i] = VH[gi]; }
            float cs[16]; cs[0] = g[0];
#pragma unroll
            for (int i = 1; i < 16; ++i) cs[i] = cs[i - 1] + g[i];
            LAS float* tots = (LAS float*)(lds + HT);
            tots[seg * 128 + d] = cs[15]; tots[512 + seg * 128 + d] = cs[0];
            __syncthreads();
            float Bpre[4], rho[4]; { float a = 0.f;
#pragma unroll
              for (int i = 0; i < 4; ++i) { Bpre[i] = a; rho[i] = a + tots[512 + i * 128 + d]; a += tots[i * 128 + d]; }
              const float btot = a; float myB = 0.f;
#pragma unroll
              for (int i = 0; i < 4; ++i) myB = (i == seg) ? Bpre[i] : myB;
              if (seg == 0) DEC[(size_t)unit * 128 + d] = __expf(btot);
              unsigned kh[8];
#pragma unroll
              for (int i = 0; i < 16; ++i) { const float bt = myB + cs[i]; const float kk = 1.0f - __expf(g[i]);
                  const size_t gi = (row0 + 16 * seg + i) * 512 + col0 + d;
                  QH[gi] = (bf16)f2bf(qv[i] * __expf(bt));
                  *(LAS bf16*)(lds + HQ + (16 * seg + i) * 272 + d * 2) = (bf16)f2bf(qv[i] * __expf(cs[i] - cs[0]));
#pragma unroll
                  for (int iv = 0; iv < 4; ++iv) if (iv >= seg) { const int off = iv == 0 ? 0 : (iv == 1 ? 16 : (iv == 2 ? 48 : 96));
                      *(LAS bf16*)(lds + HK + (off + 16 * seg + i) * 272 + d * 2) = (bf16)f2bf(kk * __expf(fminf(rho[iv] - bt, 80.f))); }
                  const unsigned kb_ = f2bf(kk * __expf(btot - bt));
                  if (i & 1) kh[i >> 1] |= kb_ << 16; else kh[i >> 1] = kb_; }
              v4u w0, w1; w0.x = kh[0]; w0.y = kh[1]; w0.z = kh[2]; w0.w = kh[3]; w1.x = kh[4]; w1.y = kh[5]; w1.z = kh[6]; w1.w = kh[7];
              *(LAS v4u*)(lds + HKH + d * 144 + 32 * seg) = w0; *(LAS v4u*)(lds + HKH + d * 144 + 32 * seg + 16) = w1;
              v4u u0, u1; u0.x = vraw[0] | (vraw[1] << 16); u0.y = vraw[2] | (vraw[3] << 16); u0.z = vraw[4] | (vraw[5] << 16); u0.w = vraw[6] | (vraw[7] << 16);
              u1.x = vraw[8] | (vraw[9] << 16); u1.y = vraw[10] | (vraw[11] << 16); u1.z = vraw[12] | (vraw[13] << 16); u1.w = vraw[14] | (vraw[15] << 16);
              *(LAS v4u*)(lds + HV + d * 144 + 32 * seg) = u0; *(LAS v4u*)(lds + HV + d * 144 + 32 * seg + 16) = u1; }
            __syncthreads();
            for (int ti = wave; ti < 10; ti += 8) {
                const int i = ti < 1 ? 0 : (ti < 3 ? 1 : (ti < 6 ? 2 : 3)); const int jb = ti - (i * (i + 1)) / 2; const int off = i == 0 ? 0 : (i == 1 ? 16 : (i == 2 ? 48 : 96));
                pg8::f32x4 acc = {0.f, 0.f, 0.f, 0.f};
#pragma unroll
                for (int ks = 0; ks < 4; ++ks) { const bf16x8v_ a = *(const LAS bf16x8v_*)(lds + HQ + (16 * i + fr) * 272 + (32 * ks + 8 * fq) * 2), bb = *(const LAS bf16x8v_*)(lds + HK + (off + 16 * jb + fr) * 272 + (32 * ks + 8 * fq) * 2);
                    acc = __builtin_amdgcn_mfma_f32_16x16x32_bf16(a, bb, acc, 0, 0, 0); }
#pragma unroll
                for (int r = 0; r < 4; ++r) { const float v = (i != jb || fr <= 4 * fq + r) ? acc[r] : 0.f; *(LAS bf16*)(lds + HA + (16 * i + 4 * fq + r) * 144 + (16 * jb + fr) * 2) = (bf16)f2bf(v); }
            }
            if (wave == 2 || wave == 3) { const int i = wave == 2 ? 0 : 2;
#pragma unroll
                for (int r = 0; r < 4; ++r) *(LAS bf16*)(lds + HA + (16 * i + 4 * fq + r) * 144 + (16 * (i + 1) + fr) * 2) = (bf16)0; }
            __syncthreads();
#pragma unroll
            for (int mt = 0; mt < 4; ++mt) { pg8::f32x4 acc = {0.f, 0.f, 0.f, 0.f};
#pragma unroll
                for (int kk = 0; kk < 2; ++kk) if (kk == 0 || mt >= 2) { const bf16x8v_ a = *(const LAS bf16x8v_*)(lds + HA + (16 * mt + fr) * 144 + (32 * kk + 8 * fq) * 2), bb = *(const LAS bf16x8v_*)(lds + HV + (16 * wave + fr) * 144 + (32 * kk + 8 * fq) * 2);
                    acc = __builtin_amdgcn_mfma_f32_16x16x32_bf16(a, bb, acc, 0, 0, 0); }
#pragma unroll
                for (int r = 0; r < 4; ++r) GH[(row0 + 16 * mt + 4 * fq + r) * 512 + col0 + 16 * wave + fr] = acc[r]; }
#pragma unroll
            for (int mt = 0; mt < 8; ++mt) { pg8::f32x4 acc = {0.f, 0.f, 0.f, 0.f};
#pragma unroll
                for (int kk = 0; kk < 2; ++kk) { const bf16x8v_ a = *(const LAS bf16x8v_*)(lds + HV + (16 * mt + fr) * 144 + (32 * kk + 8 * fq) * 2), bb = *(const LAS bf16x8v_*)(lds + HKH + (16 * wave + fr) * 144 + (32 * kk + 8 * fq) * 2);
                    acc = __builtin_amdgcn_mfma_f32_16x16x32_bf16(a, bb, acc, 0, 0, 0); }
#pragma unroll
                for (int r = 0; r < 4; ++r) DS[(size_t)unit * 16384 + (16 * mt + 4 * fq + r) * 128 + 16 * wave + fr] = (bf16)f2bf(acc[r]); }
            __syncthreads();
        }
    }
    {
        typedef short bf16x8v_ __attribute__((ext_vector_type(8)));
        const int bg = vcu >> 5, kind = (vcu >> 4) & 1, slab = vcu & 15, fr = lane & 15, fq = lane >> 4;
        const bf16* ap = KV + (size_t)kind * 8 * T * 64 + (size_t)bg * T * 64 + (size_t)(16 * slab + fr) * 1024 + 8 * fq;
        const bf16* bp0 = (const bf16*)(ws + WS_W1T) + (size_t)kind * 256 * 2048 + (size_t)(32 * wave + fr) * 2048 + 8 * fq;
        pg8::f32x4 acc0 = {0.f, 0.f, 0.f, 0.f}, acc1 = {0.f, 0.f, 0.f, 0.f};
#pragma unroll 8
        for (int ks = 0; ks < 64; ++ks) { const bf16x8v_ a = *(const GAS bf16x8v_*)(ap + 32 * ks), b0 = *(const GAS bf16x8v_*)(bp0 + 32 * ks), b1 = *(const GAS bf16x8v_*)(bp0 + 16 * 2048 + 32 * ks);
            acc0 = __builtin_amdgcn_mfma_f32_16x16x32_bf16(a, b0, acc0, 0, 0, 0); acc1 = __builtin_amdgcn_mfma_f32_16x16x32_bf16(a, b1, acc1, 0, 0, 0); }
        float pb0 = 0.f, pb1 = 0.f; { const float* PB = (const float*)(ws + WS_PB) + kind * 32 * 256 + 32 * wave + fr;
            for (int s = 0; s < 32; ++s) { pb0 += PB[s * 256]; pb1 += PB[s * 256 + 16]; } }
        LAS bf16* hid = (LAS bf16*)lds;
#pragma unroll
        for (int r = 0; r < 4; ++r) { const float x0 = acc0[r] + pb0, x1 = acc1[r] + pb1;
            const float t0 = 1.0f - 2.0f / (__expf(2.0f * 0.7978845608028654f * (x0 + 0.044715f * x0 * x0 * x0)) + 1.0f), t1 = 1.0f - 2.0f / (__expf(2.0f * 0.7978845608028654f * (x1 + 0.044715f * x1 * x1 * x1)) + 1.0f);
            hid[(4 * fq + r) * 264 + 32 * wave + fr] = (bf16)f2bf(0.5f * x0 * (1.0f + t0)); hid[(4 * fq + r) * 264 + 32 * wave + 16 + fr] = (bf16)f2bf(0.5f * x1 * (1.0f + t1)); }
        __syncthreads();
        if (wave < 4) { pg8::f32x4 acc = {0.f, 0.f, 0.f, 0.f}; const bf16* w2t = (const bf16*)(ws + WS_W2T) + (size_t)kind * 64 * 256 + (size_t)(16 * wave + fr) * 256 + 8 * fq;
#pragma unroll
            for (int ks = 0; ks < 8; ++ks) { const bf16x8v_ a = *(const LAS bf16x8v_*)(hid + fr * 264 + 32 * ks + 8 * fq), bb = *(const GAS bf16x8v_*)(w2t + 32 * ks); acc = __builtin_amdgcn_mfma_f32_16x16x32_bf16(a, bb, acc, 0, 0, 0); }
#pragma unroll
            for (int r = 0; r < 4; ++r) { const int n = 16 * slab + 4 * fq + r, dd = 16 * wave + fr; const bf16 v = (bf16)f2bf(n < 255 ? acc[r] : 0.f);
                if (kind) ((bf16*)(ws + WS_VCMP))[((size_t)bg * 64 + dd) * 256 + n] = v; else ((bf16*)(ws + WS_KCMP))[((size_t)bg * 256 + n) * 64 + dd] = v; } }
        __syncthreads();
    }
    xcd_barrier(bar);

    if (vcu < 64) {
        const float* DEC = (const float*)(ws + WS_DEC); bf16* DS = (bf16*)(ws + WS_DS);
        const int gid = vcu * 512 + tid; const int bh = gid >> 11, e0 = (gid & 2047) * 8, dk0 = e0 & 127;
        float S[8];
#pragma unroll
        for (int i = 0; i < 8; ++i) S[i] = 0.f;
        for (int c = 0; c < 64; ++c) {
            GAS v4u* p = (GAS v4u*)(DS + ((size_t)(bh * 64 + c)) * 16384 + e0); const v4u dsv = *p;
            const f32x4 d0 = *(const GAS f32x4*)(DEC + (size_t)(bh * 64 + c) * 128 + dk0), d1 = *(const GAS f32x4*)(DEC + (size_t)(bh * 64 + c) * 128 + dk0 + 4);
            v4u o; o.x = pk2(S[0], S[1]); o.y = pk2(S[2], S[3]); o.z = pk2(S[4], S[5]); o.w = pk2(S[6], S[7]); *p = o;
            S[0] = d0.x * S[0] + bf2f(dsv.x & 0xffffu); S[1] = d0.y * S[1] + bf2f(dsv.x >> 16); S[2] = d0.z * S[2] + bf2f(dsv.y & 0xffffu); S[3] = d0.w * S[3] + bf2f(dsv.y >> 16);
            S[4] = d1.x * S[4] + bf2f(dsv.z & 0xffffu); S[5] = d1.y * S[5] + bf2f(dsv.z >> 16); S[6] = d1.z * S[6] + bf2f(dsv.w & 0xffffu); S[7] = d1.w * S[7] + bf2f(dsv.w >> 16);
        }
    }
    xcd_barrier(bar);

    {
        typedef short bf16x8v_ __attribute__((ext_vector_type(8)));
        const bf16* DS = (const bf16*)(ws + WS_DS);
        const int fr = lane & 15, fq = lane >> 4;
        LAS float* part = (LAS float*)lds;
        for (int rep = 0; rep < 4; ++rep) {
            const int unit = vcu * 4 + rep; const int bh = unit >> 6, c = unit & 63, b = bh >> 2, h = bh & 3;
            const size_t row0 = (size_t)b * T + 64 * c; const int col0 = h * 128;
            bf16x8v_ bfr[4];
#pragma unroll
            for (int ks = 0; ks < 4; ++ks) bfr[ks] = *(const GAS bf16x8v_*)(DS + (size_t)unit * 16384 + (16 * wave + fr) * 128 + 32 * ks + 8 * fq);
            pg8::f32x4 o[4];
#pragma unroll
            for (int mt = 0; mt < 4; ++mt) { pg8::f32x4 acc = {0.f, 0.f, 0.f, 0.f};
#pragma unroll
                for (int ks = 0; ks < 4; ++ks) { const bf16x8v_ a = *(const GAS bf16x8v_*)(QH + (row0 + 16 * mt + fr) * 512 + col0 + 32 * ks + 8 * fq); acc = __builtin_amdgcn_mfma_f32_16x16x32_bf16(a, bfr[ks], acc, 0, 0, 0); }
#pragma unroll
                for (int r = 0; r < 4; ++r) { acc[r] += GH[(row0 + 16 * mt + 4 * fq + r) * 512 + col0 + 16 * wave + fr];
                    float sq = acc[r] * acc[r]; sq += __shfl_xor(sq, 1); sq += __shfl_xor(sq, 2); sq += __shfl_xor(sq, 4); sq += __shfl_xor(sq, 8);
                    if (fr == 0) part[wave * 64 + 16 * mt + 4 * fq + r] = sq; }
                o[mt] = acc; }
            __syncthreads();
#pragma unroll
            for (int mt = 0; mt < 4; ++mt)
#pragma unroll
                for (int r = 0; r < 4; ++r) { const int tt = 16 * mt + 4 * fq + r; float ss = 0.f;
#pragma unroll
                    for (int w = 0; w < 8; ++w) ss += part[w * 64 + tt];
                    const float rs = 1.0f / sqrtf(ss * (1.0f / 128.0f) + RMS_EPS); const int col = col0 + 16 * wave + fr; const size_t row = row0 + tt;
                    Y[row * D + col] = (bf16)f2bf(o[mt][r] * rs * hg_norm_g[col] * bf2f(SG[row * 512 + col])); }
            __syncthreads();
        }
    }

    {
        const bf16* KC2 = (const bf16*)(ws + WS_KCMP); const bf16* VC2T = (const bf16*)(ws + WS_VCMP);
        const bf16* KS = KV + (size_t)2 * 8 * T * 64; const bf16* VST = KV + (size_t)3 * 8 * T * 64; const bf16* KW = KV + (size_t)4 * 8 * T * 64; const bf16* VWT = KV + (size_t)5 * 8 * T * 64;
        LAS float* impH = (LAS float*)(lds + NSA_IMP); LAS unsigned long long* selm = (LAS unsigned long long*)(lds + NSA_SEL);
        const int hh = wave >> 1, th = wave & 1, rA = lane & 31, h2 = lane >> 5;
        for (int rep = 0; rep < 2; ++rep) {
            const int bg = vcu >> 5, qt = rep ? 63 - (vcu & 31) : (vcu & 31), b = bg >> 1, g = bg & 1, cur = qt;
            const int tl = th * 32 + rA, tq = 64 * qt + tl; const size_t row = (size_t)b * T + tq;
            bf16x8v qf[4];
#pragma unroll
            for (int ks = 0; ks < 4; ++ks) qf[ks] = *(const GAS bf16x8v*)(NQ + row * 512 + g * 256 + hh * 64 + 16 * ks + 8 * h2);
            const float slope2 = exp2f(-(float)(g * 4 + hh + 1)) * LOG2E;
            const float* gatep = GATE + row * 32 + g * 12 + hh * 3;
            const float gc = gatep[0], gs = gatep[1], gwn = gatep[2];
            f32x16 outv[2], O[2];
#pragma unroll
            for (int r = 0; r < 16; ++r) { outv[0][r] = 0.f; outv[1][r] = 0.f; }
            for (int i = tid; i < 4 * 64 * 64; i += 512) impH[i] = 0.f;
            __syncthreads();
            LAS float* improw = impH + (hh * 64 + tl) * 64;
            { const unsigned long long ctiles = (2ull << ((4 * cur + 2) >> 6)) - 1ull;
              float m = -1e30f, l = 0.f;
              nsa_loop<0>(ctiles, KC2 + (size_t)bg * 256 * 64, VC2T + (size_t)bg * 64 * 256, 256, lds, tid, qf, O, m, l, slope2, tq, cur, 0ull, rA, h2, improw);
              const float lt = l + __shfl_xor(l, 32); float inv = lt > 0.f ? 1.0f / lt : 0.f;
#pragma unroll
              for (int r = 0; r < 16; ++r) { O[0][r] = 0.f; O[1][r] = 0.f; }
              nsa_loop<1>(ctiles, KC2 + (size_t)bg * 256 * 64, VC2T + (size_t)bg * 64 * 256, 256, lds, tid, qf, O, m, inv, slope2, tq, cur, 0ull, rA, h2, improw);
#pragma unroll
              for (int r = 0; r < 16; ++r) { outv[0][r] += gc * O[0][r]; outv[1][r] += gc * O[1][r]; } }
            for (int i = 0; i < 8; ++i) { const int tk = 8 * wave + i; const int t = 64 * qt + tk;
                float v = impH[(0 * 64 + tk) * 64 + lane] + impH[(1 * 64 + tk) * 64 + lane] + impH[(2 * 64 + tk) * 64 + lane] + impH[(3 * 64 + tk) * 64 + lane];
                if (lane == 0 || lane == cur || lane == cur - 1) v = 1e4f;
                if (lane * 64 > t) v = NEGF;
                unsigned u = __builtin_bit_cast(unsigned, v); u = (u & 0x80000000u) ? ~u : (u | 0x80000000u); u = (u & ~63u) | (unsigned)(63 - lane);
                unsigned Tt = 0u;
                for (int bit = 31; bit >= 0; --bit) { const unsigned cand = Tt | (1u << bit); const int cnt = __builtin_popcountll(__ballot(u >= cand)); if (cnt >= 16) Tt = cand; }
                const unsigned long long msk = __ballot(u >= Tt);
                if (lane == 0) selm[tk] = msk; }
            __syncthreads();
            unsigned long long mymask, uni;
            { const unsigned long long mm = selm[lane]; unsigned lo = (unsigned)mm, hi = (unsigned)(mm >> 32);
#pragma unroll
              for (int o = 1; o < 64; o <<= 1) { lo |= __shfl_xor(lo, o); hi |= __shfl_xor(hi, o); }
              uni = (unsigned long long)lo | ((unsigned long long)hi << 32); mymask = selm[tl]; }
            uni &= (cur == 63) ? ~0ull : ((2ull << cur) - 1ull);
            { float m = -1e30f, l = 0.f;
#pragma unroll
              for (int r = 0; r < 16; ++r) { O[0][r] = 0.f; O[1][r] = 0.f; }
              nsa_loop<2>(uni, KS + (size_t)bg * T * 64, VST + (size_t)bg * 64 * T, T, lds, tid, qf, O, m, l, slope2, tq, cur, mymask, rA, h2, improw);
              const float lt = l + __shfl_xor(l, 32); const float sc = lt > 0.f ? gs / lt : 0.f;
#pragma unroll
              for (int r = 0; r < 16; ++r) { outv[0][r] += sc * O[0][r]; outv[1][r] += sc * O[1][r]; } }
            { float m = -1e30f, l = 0.f;
#pragma unroll
              for (int r = 0; r < 16; ++r) { O[0][r] = 0.f; O[1][r] = 0.f; }
              const int j0 = cur >= 8 ? cur - 8 : 0;
              const unsigned long long wt = ((cur == 63) ? ~0ull : ((2ull << cur) - 1ull)) & ~((1ull << j0) - 1ull);
              nsa_loop<3>(wt, KW + (size_t)bg * T * 64, VWT + (size_t)bg * 64 * T, T, lds, tid, qf, O, m, l, slope2, tq, cur, 0ull, rA, h2, improw);
              const float lt = l + __shfl_xor(l, 32); const float sc = lt > 0.f ? gwn / lt : 0.f;
#pragma unroll
              for (int r = 0; r < 16; ++r) { outv[0][r] += sc * O[0][r]; outv[1][r] += sc * O[1][r]; } }
            bf16* yrow = Y + row * D + 512 + g * 256 + hh * 64 + 4 * h2;
#pragma unroll
            for (int dt = 0; dt < 2; ++dt)
#pragma unroll
                for (int g4 = 0; g4 < 4; ++g4) { const unsigned long long w = (unsigned long long)pk2(outv[dt][4 * g4], outv[dt][4 * g4 + 1]) | ((unsigned long long)pk2(outv[dt][4 * g4 + 2], outv[dt][4 * g4 + 3]) << 32);
                    *(GAS unsigned long long*)(yrow + 32 * dt + 8 * g4) = w; }
            __syncthreads();
        }
    }
    xcd_barrier(bar);

    {
        pg8::Gemm g{Y, Wo_t, M, D, D}; pg8::StaticOrder S; S.init(M, D, G, bx);
        pg8::EpiF32 E{out, D};
        pg8::gemm_phase<pg8::EpiF32, pg8::StaticOrder, true, true>(lds, g, S, E);
    }
    xcd_barrier(bar);

    {
        for (int row = gw; row < M; row += NGW) { const int b = row >> 12; const float* ad = ADA + (size_t)b * 6144;
            const GAS f32x4* xr = (const GAS f32x4*)(xin + (size_t)row * D) + lane; GAS f32x4* mr = (GAS f32x4*)(out + (size_t)row * D) + lane;
            f32x4 v[4]; float s = 0.f;
#pragma unroll
            for (int j = 0; j < 4; ++j) { const f32x4 g1 = *(const GAS f32x4*)(ad + 2048 + 4 * lane + 256 * j); v[j] = xr[64 * j] * ALPHA + g1 * mr[64 * j]; s += (v[j].x + v[j].y) + (v[j].z + v[j].w); }
            const float mean = wave_sum(s) * (1.f / D); float s2 = 0.f;
#pragma unroll
            for (int j = 0; j < 4; ++j) { v[j] = v[j] - mean; s2 += (v[j].x * v[j].x + v[j].y * v[j].y) + (v[j].z * v[j].z + v[j].w * v[j].w); }
            const float rstd = 1.f / sqrtf(wave_sum(s2) * (1.f / D) + LN_EPS);
            GAS unsigned long long* o8 = (GAS unsigned long long*)(XN + (size_t)row * D) + lane;
#pragma unroll
            for (int j = 0; j < 4; ++j) { const int c = 4 * lane + 256 * j; const f32x4 lg = *(const GAS f32x4*)(ln1_g + c), lb_ = *(const GAS f32x4*)(ln1_b + c);
                const f32x4 x1 = v[j] * rstd * lg + lb_; mr[64 * j] = x1;
                const f32x4 sh = *(const GAS f32x4*)(ad + 3072 + c), sc = *(const GAS f32x4*)(ad + 4096 + c); const f32x4 h = x1 * (sc + 1.0f) + sh;
                o8[64 * j] = (unsigned long long)pk2(h.x, h.y) | ((unsigned long long)pk2(h.z, h.w) << 32); } }
    }
    xcd_barrier(bar);

    {
        pg8::Gemm g{XN, Wup_t, M, NUP, D}; pg8::StaticOrder S; S.init(M, NUP, G, bx);
        pg8::EpiSwiGLU E{U, FF};
        pg8::gemm_phase<pg8::EpiSwiGLU, pg8::StaticOrder, true, true>(lds, g, S, E);
    }
    xcd_barrier(bar);

    {
        pg8::Gemm g{U, Wdn_t, M, D, FF}; pg8::StaticOrder S; S.init(M, D, G, bx);
        pg8::EpiF32 E{FFN, D};
        pg8::gemm_phase<pg8::EpiF32, pg8::StaticOrder, true, true>(lds, g, S, E);
    }
    xcd_barrier(bar);

    {
        for (int row = gw; row < M; row += NGW) { const int b = row >> 12; const float* ad = ADA + (size_t)b * 6144;
            GAS f32x4* xr = (GAS f32x4*)(out + (size_t)row * D) + lane; const GAS f32x4* fr_ = (const GAS f32x4*)(FFN + (size_t)row * D) + lane;
            f32x4 v[4]; float s = 0.f;
#pragma unroll
            for (int j = 0; j < 4; ++j) { const f32x4 g2 = *(const GAS f32x4*)(ad + 5120 + 4 * lane + 256 * j); v[j] = xr[64 * j] * ALPHA + g2 * fr_[64 * j]; s += (v[j].x + v[j].y) + (v[j].z + v[j].w); }
            const float mean = wave_sum(s) * (1.f / D); float s2 = 0.f;
#pragma unroll
            for (int j = 0; j < 4; ++j) { v[j] = v[j] - mean; s2 += (v[j].x * v[j].x + v[j].y * v[j].y) + (v[j].z * v[j].z + v[j].w * v[j].w); }
            const float rstd = 1.f / sqrtf(wave_sum(s2) * (1.f / D) + LN_EPS);
#pragma unroll
            for (int j = 0; j < 4; ++j) { const int c = 4 * lane + 256 * j; const f32x4 lg = *(const GAS f32x4*)(ln2_g + c), lb_ = *(const GAS f32x4*)(ln2_b + c);
                xr[64 * j] = v[j] * rstd * lg + lb_; } }
    }
}

#undef xin
#undef cvec
#undef w_ada
#undef b_ada
#undef w_in
#undef lbl
#undef hg_norm_g
#undef pos_k
#undef w1_k
#undef w2_k
#undef pos_v
#undef w1_v
#undef w2_v
#undef w_out
#undef ln1_g
#undef ln1_b
#undef ffn_w1
#undef ffn_w3
#undef ffn_w2
#undef ln2_g
#undef ln2_b
#undef out
#undef ADAP
#undef ADA
#undef Win_t
#undef Wo_t
#undef Wup_t
#undef Wdn_t
#undef XN
#undef Y
#undef QH
#undef GH
#undef VH
#undef SG
#undef NQ
#undef KV
#undef GATE
#undef U
#undef FFN
extern "C" void kernel_launch(void* const* d_in, const int* in_sizes, int n_in, void* d_out, int out_size, void* d_ws, size_t ws_size, hipStream_t stream) {
    static int grid = 0;
    if (grid == 0) {
        if (n_in != 21 || in_sizes[0] != M * D || out_size != M * D || ws_size < WS_END) { fprintf(stderr, "kernel_launch: unexpected problem (n_in %d, in0 %d, out %d, ws %zu); nothing launched\n", n_in, n_in > 0 ? in_sizes[0] : -1, out_size, ws_size); grid = -1; return; }
        int dev = 0, cus = 0, per_cu = 0;
        if (hipGetDevice(&dev) != hipSuccess || hipDeviceGetAttribute(&cus, hipDeviceAttributeMultiprocessorCount, dev) != hipSuccess) { grid = -1; return; }
        if (hipFuncSetAttribute((const void*)fwd_kernel, hipFuncAttributeMaxDynamicSharedMemorySize, LDS_BYTES) != hipSuccess) { fprintf(stderr, "kernel_launch: hipFuncSetAttribute failed\n"); grid = -1; return; }
        if (hipOccupancyMaxActiveBlocksPerMultiprocessor(&per_cu, (const void*)fwd_kernel, NWAVES * 64, LDS_BYTES) != hipSuccess || per_cu < 1) { fprintf(stderr, "kernel_launch: occupancy query says %d blocks per CU\n", per_cu); }
        (void)hipGetLastError();
        grid = cus;
        if (grid != 256) fprintf(stderr, "kernel_launch: %d CUs (expected 256)\n", grid);
    }
    if (grid < 0) return;
    if (hipMemsetAsync((char*)d_ws + WS_CTL, 0, CTL_ZERO_BYTES, stream) != hipSuccess) { fprintf(stderr, "kernel_launch: memset failed\n"); return; }
    Args a{};
    for (int i = 0; i < 21; ++i) a.in[i] = (const float*)d_in[i];
    a.out = (float*)d_out; a.ws = (unsigned char*)d_ws;
    hipLaunchKernelGGL(fwd_kernel, dim3(grid), dim3(NWAVES * 64), LDS_BYTES, stream, a);
}
```
